# Optimizing an MI355X kernel written in HIP

```python
import math
import jax, jax.numpy as jnp
from jax import lax
import numpy as np

D_MODEL = 1024
BATCH = 2
SEQ = 8192
DEPTH = 1

GRID_W = 64
NA_HEADS = 8
NA_HEAD_DIM = 64
NA_WIDTH = NA_HEADS * NA_HEAD_DIM
NA_KH_MAX = 8
NA_KW = 16
HY_WIDTH = 512
HY_ORDER = 2
HY_SHORT_K = 3
HY_EMB_DIM = 33
HY_FILTER_HIDDEN = 64
HY_FAST_DECAY_PCT = 0.3
HY_SLOW_DECAY_PCT = 1.5
HY_DECAY_TARGET = 1e-2
N_DIR = 2
N_BRANCH = 2
D_FF = 2816
QKV_COLS = 3 * NA_WIDTH
HY_COLS = (HY_ORDER + 1) * HY_WIDTH
GATE_COLS = N_BRANCH * D_MODEL
IN_COLS = QKV_COLS + HY_COLS + GATE_COLS
DN_ALPHA = (2 * DEPTH) ** 0.25
DN_BETA = (8 * DEPTH) ** -0.25
LN_EPS = 1e-5

kernel_name = 'hybrid_na2d_hyena_macaron_deepnorm'


def layer_norm(x, g, b):
    xf = x.astype(jnp.float32)
    mu = jnp.mean(xf, axis=-1, keepdims=True)
    var = jnp.mean(jnp.square(xf - mu), axis=-1, keepdims=True)
    return ((xf - mu) * lax.rsqrt(var + LN_EPS)).astype(x.dtype) * g + b


def swiglu(x, w1, w3, w2):
    return (jax.nn.silu(x @ w1) * (x @ w3)) @ w2


def _window_starts(n, k):
    return np.clip(np.arange(n) - k // 2, 0, n - k)


def neighbourhood_attention_2d(q, k, v, rpb):
    b, L, h, dh = q.shape
    rows = L // GRID_W
    kh = min(NA_KH_MAX, rows)
    kw = NA_KW
    grid = lambda t: t.reshape(b, rows, GRID_W, h, dh).transpose(0, 3, 1, 2, 4)
    qg, kg, vg = grid(q), grid(k), grid(v)
    row_idx = _window_starts(rows, kh)[:, None] + np.arange(kh)[None, :]
    col_idx = _window_starts(GRID_W, kw)[:, None] + np.arange(kw)[None, :]
    k_band = kg[:, :, row_idx]
    v_band = vg[:, :, row_idx]
    col_sel = jax.nn.one_hot(col_idx, GRID_W, dtype=q.dtype)
    s_band = jnp.einsum('bhrqd,bhrakd->bhrqak', qg, k_band)
    s = jnp.einsum('bhrqak,qjk->bhrqaj', s_band, col_sel)
    dr = row_idx - np.arange(rows)[:, None] + (NA_KH_MAX - 1)
    dc = col_idx - np.arange(GRID_W)[:, None] + (NA_KW - 1)
    bias = rpb[:, dr[:, None, :, None], dc[None, :, None, :]]
    s = s.astype(jnp.float32) * (dh ** -0.5) + bias[None].astype(jnp.float32)
    p = jax.nn.softmax(s.reshape(b, h, rows, GRID_W, kh * kw), axis=-1)
    p = p.reshape(b, h, rows, GRID_W, kh, kw).astype(v.dtype)
    p_band = jnp.einsum('bhrqaj,qjk->bhrqak', p, col_sel)
    o = jnp.einsum('bhrqak,bhrakd->bhrqd', p_band, v_band)
    return o.transpose(0, 2, 3, 1, 4).reshape(b, L, h * dh)


def _short_conv(u, w, bias):
    L = u.shape[1]
    pad = HY_SHORT_K // 2
    up = jnp.pad(u, ((0, 0), (pad, pad), (0, 0)))
    out = bias
    for j in range(HY_SHORT_K):
        out = out + w[j] * up[:, j:j + L]
    return out


def _hyena_filters(L, fw1, fb1, fw2, fb2, fw3, fb3, freq):
    f32 = jnp.float32
    t = jnp.linspace(0.0, 1.0, L, dtype=f32)[:, None]
    bands = (HY_EMB_DIM - 1) // 2
    w = (2.0 * math.pi / L) * jnp.arange(L, dtype=f32)[:, None]
    f = jnp.linspace(1e-4, bands - 1, bands, dtype=f32)[None, :]
    z = jnp.concatenate([t, jnp.cos(f * w), -jnp.sin(f * w)], axis=-1)
    fr = freq.astype(f32)
    hdn = jnp.sin(fr * (z @ fw1.astype(f32) + fb1.astype(f32)))
    hdn = jnp.sin(fr * (hdn @ fw2.astype(f32) + fb2.astype(f32)))
    hf = hdn @ fw3.astype(f32) + fb3.astype(f32)
    hf = hf.reshape(L, N_DIR, HY_ORDER, HY_WIDTH)
    max_decay = math.log(HY_DECAY_TARGET) / HY_FAST_DECAY_PCT
    min_decay = math.log(HY_DECAY_TARGET) / HY_SLOW_DECAY_PCT
    deltas = jnp.abs(jnp.linspace(min_decay, max_decay, HY_WIDTH, dtype=f32))
    decay = jnp.exp(-t[:, :, None, None] * deltas)
    return hf * decay


def _two_sided_kernels(h):
    fwd, bwd = h[:, 0], h[:, 1]
    k = jnp.concatenate([fwd, jnp.zeros_like(fwd[:1]), bwd[1:][::-1]], axis=0)
    return k * lax.rsqrt(jnp.sum(jnp.square(k), axis=0, keepdims=True) + 1e-12)


def _fft_conv(z, k):
    L = z.shape[1]
    Z = jnp.fft.rfft(z.astype(jnp.float32), n=2 * L, axis=1)
    K = jnp.fft.rfft(k.astype(jnp.float32), n=2 * L, axis=0)
    return jnp.fft.irfft(Z * K[None], n=2 * L, axis=1)[:, :L].astype(z.dtype)


def hyena_mixer(u, short_w, short_b, fw1, fb1, fw2, fb2, fw3, fb3, freq, hy_bias):
    L = u.shape[1]
    parts = jnp.split(_short_conv(u, short_w, short_b), HY_ORDER + 1, axis=-1)
    kern = _two_sided_kernels(_hyena_filters(L, fw1, fb1, fw2, fb2, fw3, fb3, freq))
    z = parts[0]
    for n in range(HY_ORDER):
        z = parts[n + 1] * (_fft_conv(z, kern[:, n]) + hy_bias[n] * z)
    return z


def _layer(x, ln1_g, ln1_b, ffn1_w1, ffn1_w3, ffn1_w2, w_in, b_gate, na_rpb,
           hy_short_w, hy_short_b, hy_filt_w1, hy_filt_b1, hy_filt_w2, hy_filt_b2,
           hy_filt_w3, hy_filt_b3, hy_filt_freq, hy_bias, w_pa, w_pb, w_out,
           ln2_g, ln2_b, ffn2_w1, ffn2_w3, ffn2_w2, ln3_g, ln3_b):
    x = layer_norm(DN_ALPHA * x + 0.5 * swiglu(x, ffn1_w1, ffn1_w3, ffn1_w2), ln1_g, ln1_b)
    b, L, _ = x.shape
    proj = x @ w_in
    qkv, hy_u, gate_logits = jnp.split(proj, [QKV_COLS, QKV_COLS + HY_COLS], axis=-1)
    q, k, v = [t.reshape(b, L, NA_HEADS, NA_HEAD_DIM) for t in jnp.split(qkv, 3, axis=-1)]
    y_a = neighbourhood_attention_2d(q, k, v, na_rpb)
    y_b = hyena_mixer(hy_u, hy_short_w, hy_short_b, hy_filt_w1, hy_filt_b1, hy_filt_w2,
                      hy_filt_b2, hy_filt_w3, hy_filt_b3, hy_filt_freq, hy_bias)
    g_a, g_b = jnp.split(jax.nn.sigmoid(gate_logits + b_gate), N_BRANCH, axis=-1)
    mix = (g_a * (y_a @ w_pa) + g_b * (y_b @ w_pb)) @ w_out
    x = layer_norm(DN_ALPHA * x + mix, ln2_g, ln2_b)
    x = layer_norm(DN_ALPHA * x + 0.5 * swiglu(x, ffn2_w1, ffn2_w3, ffn2_w2), ln3_g, ln3_b)
    return x


def setup_inputs(seed: int = 0) -> dict:
    key = jax.random.key(seed)
    ks = jax.random.split(key, 32)
    f32 = jnp.float32

    def nrm(k, shape, scale):
        return jax.random.normal(k, shape, f32) * scale

    Dp = DEPTH
    return {
        'x': jax.random.normal(ks[0], (BATCH, SEQ, D_MODEL), f32),
        'ln1_g': 1.0 + nrm(ks[1], (Dp, D_MODEL), 0.02),
        'ln1_b': nrm(ks[2], (Dp, D_MODEL), 0.02),
        'ffn1_w1': nrm(ks[3], (Dp, D_MODEL, D_FF), D_MODEL ** -0.5),
        'ffn1_w3': nrm(ks[4], (Dp, D_MODEL, D_FF), D_MODEL ** -0.5),
        'ffn1_w2': nrm(ks[5], (Dp, D_FF, D_MODEL), DN_BETA * D_FF ** -0.5),
        'w_in': nrm(ks[6], (Dp, D_MODEL, IN_COLS), D_MODEL ** -0.5),
        'b_gate': nrm(ks[7], (Dp, GATE_COLS), 0.02),
        'na_rpb': nrm(ks[8], (Dp, NA_HEADS, 2 * NA_KH_MAX - 1, 2 * NA_KW - 1), 0.02),
        'hy_short_w': nrm(ks[9], (Dp, HY_SHORT_K, HY_COLS), HY_SHORT_K ** -0.5),
        'hy_short_b': nrm(ks[10], (Dp, HY_COLS), 0.02),
        'hy_filt_w1': nrm(ks[11], (Dp, HY_EMB_DIM, HY_FILTER_HIDDEN), HY_EMB_DIM ** -0.5),
        'hy_filt_b1': nrm(ks[12], (Dp, HY_FILTER_HIDDEN), 0.02),
        'hy_filt_w2': nrm(ks[13], (Dp, HY_FILTER_HIDDEN, HY_FILTER_HIDDEN), HY_FILTER_HIDDEN ** -0.5),
        'hy_filt_b2': nrm(ks[14], (Dp, HY_FILTER_HIDDEN), 0.02),
        'hy_filt_w3': nrm(ks[15], (Dp, HY_FILTER_HIDDEN, N_DIR * HY_ORDER * HY_WIDTH), HY_FILTER_HIDDEN ** -0.5),
        'hy_filt_b3': nrm(ks[16], (Dp, N_DIR * HY_ORDER * HY_WIDTH), 0.02),
        'hy_filt_freq': 1.0 + nrm(ks[17], (Dp, HY_FILTER_HIDDEN), 0.02),
        'hy_bias': nrm(ks[18], (Dp, HY_ORDER, HY_WIDTH), 1.0),
        'w_pa': nrm(ks[19], (Dp, NA_WIDTH, D_MODEL), DN_BETA * NA_WIDTH ** -0.5),
        'w_pb': nrm(ks[20], (Dp, HY_WIDTH, D_MODEL), DN_BETA * HY_WIDTH ** -0.5),
        'w_out': nrm(ks[21], (Dp, D_MODEL, D_MODEL), DN_BETA * D_MODEL ** -0.5),
        'ln2_g': 1.0 + nrm(ks[22], (Dp, D_MODEL), 0.02),
        'ln2_b': nrm(ks[23], (Dp, D_MODEL), 0.02),
        'ffn2_w1': nrm(ks[24], (Dp, D_MODEL, D_FF), D_MODEL ** -0.5),
        'ffn2_w3': nrm(ks[25], (Dp, D_MODEL, D_FF), D_MODEL ** -0.5),
        'ffn2_w2': nrm(ks[26], (Dp, D_FF, D_MODEL), DN_BETA * D_FF ** -0.5),
        'ln3_g': 1.0 + nrm(ks[27], (Dp, D_MODEL), 0.02),
        'ln3_b': nrm(ks[28], (Dp, D_MODEL), 0.02),
    }


def reference(x, ln1_g, ln1_b, ffn1_w1, ffn1_w3, ffn1_w2, w_in, b_gate, na_rpb,
              hy_short_w, hy_short_b, hy_filt_w1, hy_filt_b1, hy_filt_w2, hy_filt_b2,
              hy_filt_w3, hy_filt_b3, hy_filt_freq, hy_bias, w_pa, w_pb, w_out,
              ln2_g, ln2_b, ffn2_w1, ffn2_w3, ffn2_w2, ln3_g, ln3_b):
    for i in range(DEPTH):
        x = _layer(x, ln1_g[i], ln1_b[i], ffn1_w1[i], ffn1_w3[i], ffn1_w2[i], w_in[i],
                   b_gate[i], na_rpb[i], hy_short_w[i], hy_short_b[i], hy_filt_w1[i],
                   hy_filt_b1[i], hy_filt_w2[i], hy_filt_b2[i], hy_filt_w3[i], hy_filt_b3[i],
                   hy_filt_freq[i], hy_bias[i], w_pa[i], w_pb[i], w_out[i], ln2_g[i],
                   ln2_b[i], ffn2_w1[i], ffn2_w3[i], ffn2_w2[i], ln3_g[i], ln3_b[i])
    return x
```

```cpp
#include <hip/hip_runtime.h>
#include <hip/hip_cooperative_groups.h>
#include <cstdio>
#include <cstdint>
namespace cg = cooperative_groups;
namespace pg8 {
#define PG8_LAS __attribute__((address_space(3)))
typedef unsigned short bf16_t;
typedef short bf16x8 __attribute__((ext_vector_type(8)));
typedef float f32x4 __attribute__((ext_vector_type(4)));
typedef unsigned u32x4 __attribute__((ext_vector_type(4)));
constexpr int BM = 256, BK = 64, HALF = 128, HTB = HALF * BK * 2  , STAGE_BYTES = 8 * HTB, NXCD = 8, WGM = 8;

__host__ __device__ __forceinline__ int lds_byte(int r, int c) { const int st = (r >> 4) * 2 + (c >> 5), rr = r & 15, cc = c & 31, ob = rr * 64 + cc * 2; return st * 1024 + (ob ^ (((ob >> 9) & 1) << 5)); }
__host__ __device__ __forceinline__ void stage_rc(int b, int& R, int& C) { const int st = b / 1024, sb = b % 1024, swz = sb ^ (((sb >> 9) & 1) << 5); R = (st >> 1) * 16 + swz / 64; C = (st & 1) * 32 + (swz % 64) / 2; }
__host__ __device__ __forceinline__ int perm32(int rho) { const int n = rho >> 4, i = rho & 15; return 8 * (i >> 2) + 4 * n + (i & 3); }

struct Unit { int pm, pn; };
struct Gemm { const bf16_t* A; const bf16_t* Bt; int M, N, K; };

struct StaticOrder {
    int nM, nN, nwg, G, c;
    __host__ __device__ void init(int M, int N, int G_, int c_) { nM = M / BM; nN = N / BM; nwg = nM * nN; G = G_; c = c_; }
    __host__ __device__ bool next(int i, Unit& u) const {
        const long L = (long)i * G + c; if (L >= nwg) return false;
        int wgid = (int)L; { const int q = nwg / NXCD, r = nwg % NXCD, xcd = wgid % NXCD, off = wgid / NXCD; wgid = (xcd < r ? xcd * (q + 1) : r * (q + 1) + (xcd - r) * q) + off; }
        const int nig = WGM * nN, gid = wgid / nig, fm = gid * WGM, gsz = (nM - fm) < WGM ? (nM - fm) : WGM;
        u.pm = fm + ((wgid % nig) % gsz); u.pn = (wgid % nig) / gsz; return true;
    }
    __device__ __forceinline__ void a_ready(const Unit&) const {}
    __device__ __forceinline__ void done(const Unit&) const {}
};

__device__ __forceinline__ unsigned cvt_pk_bf16(float lo, float hi) { unsigned r; asm volatile("v_cvt_pk_bf16_f32 %0, %1, %2" : "=v"(r) : "v"(lo), "v"(hi)); return r; }
template <class Epi, class Sched, bool ALIGN_EPI = false, bool SP2 = false>
__device__ __forceinline__ void gemm_phase(PG8_LAS unsigned char* lds, const Gemm g, const Sched& S, const Epi& E) {
    const int tid = threadIdx.x, wid = __builtin_amdgcn_readfirstlane(tid >> 6), lane = tid & 63, wr = wid >> 2, wc = wid & 3, fr = lane & 15, fq = lane >> 4;
    const int K = g.K, nt = K / BK;
    unsigned voffA[2], voffB[2];
#pragma unroll
    for (int i = 0; i < 2; ++i) { int R, C; stage_rc(tid * 16 + i * 8192, R, C); const int Rb = Epi::PERM ? ((R & ~31) + perm32(R & 31)) : R;
        voffA[i] = (unsigned)(R * K + C) * 2u; voffB[i] = (unsigned)(Rb * K + C) * 2u; }
    const size_t kstep = (size_t)(BK * 2);
    const size_t hstep = (size_t)HALF * K * 2;
    const size_t tstep = 2 * hstep;
    const unsigned ldsw = (unsigned)wid * 1024u;
    const int aoff = lds_byte(wr * 64 + fr, fq * 8), boff = lds_byte(wc * 32 + fr, fq * 8);
#define PG8_SA(b, h) (((b) * 2 + (h)) * HTB)
#define PG8_SB(b, h) ((4 + (b) * 2 + (h)) * HTB)
#define PG8_STAGE(bufoff, gbase, voff) do { _Pragma("unroll") for (int _i = 0; _i < 2; ++_i) \
        __builtin_amdgcn_global_load_lds((const unsigned*)((const char*)(gbase) + (voff)[_i]), (PG8_LAS unsigned*)(lds + (bufoff) + ldsw + _i * 8192), 16, 0, 0); } while (0)
#define PG8_LDA(dst, b, h) do { _Pragma("unroll") for (int m = 0; m < 4; ++m) _Pragma("unroll") for (int k = 0; k < 2; ++k) dst[m][k] = *(const PG8_LAS bf16x8*)(lds + PG8_SA(b, h) + aoff + m * 2048 + k * 1024); } while (0)
#define PG8_LDB(dst, b, h) do { _Pragma("unroll") for (int n = 0; n < 2; ++n) _Pragma("unroll") for (int k = 0; k < 2; ++k) dst[n][k] = *(const PG8_LAS bf16x8*)(lds + PG8_SB(b, h) + boff + n * 2048 + k * 1024); } while (0)
#define PG8_MMA(ai, bj, At, Bt) do { __builtin_amdgcn_s_setprio(1); _Pragma("unroll") for (int m = 0; m < 4; ++m) _Pragma("unroll") for (int n = 0; n < 2; ++n) _Pragma("unroll") for (int k = 0; k < 2; ++k) \
        acc[ai][bj][m][n] = __builtin_amdgcn_mfma_f32_16x16x32_bf16(Bt[n][k], At[m][k], acc[ai][bj][m][n], 0, 0, 0); __builtin_amdgcn_s_setprio(0); } while (0)
#define PG8_WAIT_V(n) asm volatile("s_waitcnt vmcnt(" #n ")" ::: "memory")
#define PG8_WAIT_L(n) asm volatile("s_waitcnt lgkmcnt(" #n ")" ::: "memory")
#define PG8_BAR __builtin_amdgcn_s_barrier()
#define PG8_SCHED __builtin_amdgcn_sched_barrier(0)
    Unit cur, nxt; int ui = 0;
    if (!S.next(0, cur)) return;
    f32x4 acc[2][2][4][2];
#pragma unroll
    for (int a = 0; a < 2; ++a)
#pragma unroll
        for (int b = 0; b < 2; ++b)
#pragma unroll
            for (int m = 0; m < 4; ++m)
#pragma unroll
                for (int n = 0; n < 2; ++n) acc[a][b][m][n] = (f32x4){0.f, 0.f, 0.f, 0.f};
    bf16x8 At[4][2], B0[2][2], B1[2][2];
    const char* cA = (const char*)g.A + (size_t)cur.pm * tstep; const char* cB = (const char*)g.Bt + (size_t)cur.pn * tstep;
    S.a_ready(cur);
    if constexpr (SP2) {
        PG8_STAGE(PG8_SB(0, 0), cB, voffB); PG8_STAGE(PG8_SB(0, 1), cB + hstep, voffB); PG8_STAGE(PG8_SA(0, 0), cA, voffA); PG8_STAGE(PG8_SA(0, 1), cA + hstep, voffA);
        if (wr == 1) PG8_BAR;
        PG8_WAIT_V(2); PG8_BAR;
        PG8_STAGE(PG8_SB(1, 0), cB + kstep, voffB); PG8_STAGE(PG8_SA(1, 0), cA + kstep, voffA); PG8_STAGE(PG8_SB(1, 1), cB + hstep + kstep, voffB);
        PG8_WAIT_V(6); PG8_BAR;
    } else {
        PG8_STAGE(PG8_SB(0, 0), cB, voffB); PG8_STAGE(PG8_SA(0, 0), cA, voffA); PG8_STAGE(PG8_SB(0, 1), cB + hstep, voffB); PG8_STAGE(PG8_SA(0, 1), cA + hstep, voffA);
        if (wr == 1) PG8_BAR;
        PG8_WAIT_V(4); PG8_BAR;
        PG8_STAGE(PG8_SB(1, 0), cB + kstep, voffB); PG8_STAGE(PG8_SA(1, 0), cA + kstep, voffA); PG8_STAGE(PG8_SB(1, 1), cB + hstep + kstep, voffB);
        PG8_WAIT_V(6); PG8_BAR;
    }
    for (;;) {
        const bool has_next = S.next(ui + 1, nxt);
        const char* nA = has_next ? (const char*)g.A + (size_t)nxt.pm * tstep : cA; const char* nB = has_next ? (const char*)g.Bt + (size_t)nxt.pn * tstep : cB;
        for (int t = 0; t < nt; t += 2) {
            const bool last = (t == nt - 2);
            const char* a1 = cA + (size_t)(t + 1) * kstep;
            const char* a2 = last ? nA : cA + (size_t)(t + 2) * kstep; const char* b2 = last ? nB : cB + (size_t)(t + 2) * kstep;
            const char* a3 = a2 + kstep; const char* b3 = b2 + kstep;
            if (last && has_next) S.a_ready(nxt);
            if constexpr (SP2) {
            PG8_LDB(B0, 0, 0); PG8_LDB(B1, 0, 1); PG8_SCHED; PG8_LDA(At, 0, 0); PG8_STAGE(PG8_SA(1, 1), a1 + hstep, voffA);
            PG8_WAIT_V(8); PG8_WAIT_L(0); PG8_BAR; PG8_MMA(0, 0, At, B0); PG8_MMA(0, 1, At, B1); PG8_BAR; PG8_SCHED;
            PG8_LDA(At, 0, 1); PG8_STAGE(PG8_SB(0, 0), b2, voffB); PG8_STAGE(PG8_SB(0, 1), b2 + hstep, voffB); PG8_STAGE(PG8_SA(0, 0), a2, voffA);
            PG8_WAIT_V(8); PG8_WAIT_L(0); PG8_BAR; PG8_MMA(1, 0, At, B0); PG8_MMA(1, 1, At, B1); PG8_BAR; PG8_SCHED;
            PG8_LDB(B0, 1, 0); PG8_LDB(B1, 1, 1); PG8_SCHED; PG8_LDA(At, 1, 0); PG8_STAGE(PG8_SA(0, 1), a2 + hstep, voffA);
            PG8_WAIT_V(8); PG8_WAIT_L(0); PG8_BAR; PG8_MMA(0, 0, At, B0); PG8_MMA(0, 1, At, B1); PG8_BAR; PG8_SCHED;
            PG8_LDA(At, 1, 1); PG8_STAGE(PG8_SB(1, 0), b3, voffB); PG8_STAGE(PG8_SB(1, 1), b3 + hstep, voffB); PG8_STAGE(PG8_SA(1, 0), a3, voffA);
            PG8_WAIT_V(8); PG8_WAIT_L(0); PG8_BAR; PG8_MMA(1, 0, At, B0); PG8_MMA(1, 1, At, B1); PG8_BAR; PG8_SCHED;
            } else {
            PG8_LDB(B0, 0, 0); PG8_SCHED; PG8_LDA(At, 0, 0); PG8_STAGE(PG8_SA(1, 1), a1 + hstep, voffA);
            PG8_WAIT_L(8); PG8_BAR; PG8_WAIT_L(0); PG8_MMA(0, 0, At, B0); PG8_BAR; PG8_SCHED;
            PG8_LDB(B1, 0, 1); PG8_STAGE(PG8_SB(0, 0), b2, voffB);
            PG8_BAR; PG8_WAIT_L(0); PG8_MMA(0, 1, At, B1); PG8_BAR;
            PG8_LDA(At, 0, 1); PG8_STAGE(PG8_SA(0, 0), a2, voffA);
            PG8_BAR; PG8_WAIT_L(0); PG8_MMA(1, 0, At, B0); PG8_BAR; PG8_SCHED;
            PG8_STAGE(PG8_SB(0, 1), b2 + hstep, voffB);
            PG8_WAIT_V(6); PG8_BAR; PG8_MMA(1, 1, At, B1); PG8_BAR;
            PG8_LDB(B0, 1, 0); PG8_SCHED; PG8_LDA(At, 1, 0); PG8_STAGE(PG8_SA(0, 1), a2 + hstep, voffA);
            PG8_WAIT_L(8); PG8_BAR; PG8_WAIT_L(0); PG8_MMA(0, 0, At, B0); PG8_BAR; PG8_SCHED;
            PG8_LDB(B1, 1, 1); PG8_STAGE(PG8_SB(1, 0), b3, voffB);
            PG8_BAR; PG8_WAIT_L(0); PG8_MMA(0, 1, At, B1); PG8_BAR;
            PG8_LDA(At, 1, 1); PG8_STAGE(PG8_SA(1, 0), a3, voffA);
            PG8_BAR; PG8_WAIT_L(0); PG8_MMA(1, 0, At, B0); PG8_BAR; PG8_SCHED;
            PG8_STAGE(PG8_SB(1, 1), b3 + hstep, voffB);
            PG8_WAIT_V(6); PG8_BAR; PG8_MMA(1, 1, At, B1); PG8_BAR;
            }
        }
        if constexpr (ALIGN_EPI) { if (wr == 0) PG8_BAR; }
        if constexpr (!Epi::AFTER_DRAIN) { E(acc, cur, wr, wc, fr, fq); S.done(cur); }
        if (!has_next) break;
#pragma unroll
        for (int a = 0; a < 2; ++a)
#pragma unroll
            for (int b = 0; b < 2; ++b)
#pragma unroll
                for (int m = 0; m < 4; ++m)
#pragma unroll
                    for (int n = 0; n < 2; ++n) acc[a][b][m][n] = (f32x4){0.f, 0.f, 0.f, 0.f};
        cur = nxt; cA = nA; cB = nB; ++ui;
        if constexpr (ALIGN_EPI) { if (wr == 1) PG8_BAR; }
    }
    PG8_WAIT_V(0);
    if constexpr (!ALIGN_EPI) { if (wr == 0) PG8_BAR; }
    PG8_BAR;
    if constexpr (Epi::AFTER_DRAIN) { E.fused(acc, cur, wr, wc, fr, fq, lds, wid, lane); S.done(cur); }
#undef PG8_SA
#undef PG8_SB
#undef PG8_STAGE
#undef PG8_LDA
#undef PG8_LDB
#undef PG8_MMA
#undef PG8_WAIT_V
#undef PG8_WAIT_L
#undef PG8_BAR
#undef PG8_SCHED
}
}
#ifndef MK_PER_PHASE
#define MK_PER_PHASE 0
#endif
#define LAS __attribute__((address_space(3)))
typedef unsigned short bf16;
typedef _Float16 f16;
typedef float f32x4 __attribute__((ext_vector_type(4)));
typedef float f32x2 __attribute__((ext_vector_type(2)));
typedef short bf16x8 __attribute__((ext_vector_type(8)));
typedef unsigned u32x4 __attribute__((ext_vector_type(4)));
typedef unsigned u32x2 __attribute__((ext_vector_type(2)));
typedef _Float16 f16x8 __attribute__((ext_vector_type(8)));

constexpr int M = 16384, D = 1024, FF = 2816, SEQ = 8192, NFFT = 16384;
constexpr float ALPHA = 1.1892071150027210667f;
constexpr float LN_EPS = 1e-5f;
constexpr int NTHR = 512, NWAVES = 8;
constexpr int LDS_BYTES = 147456;
constexpr int NPHASE = 13;

constexpr size_t MiB = 1u << 20;
constexpr size_t WS_PART = 1 * MiB;
constexpr size_t WS_W13A = 8 * MiB, WS_W2A = 19 * MiB, WS_WIN = 25 * MiB, WS_WPA = 35 * MiB, WS_WPB = 36 * MiB, WS_WOUT = 37 * MiB, WS_W13B = 39 * MiB, WS_W2B = 50 * MiB;
constexpr size_t WS_XB = 56 * MiB;
constexpr size_t WS_H = 88 * MiB;
constexpr size_t WS_Q = 88 * MiB, WS_K = 104 * MiB, WS_VT = 120 * MiB, WS_KC = 136 * MiB;
constexpr size_t WS_GATE = 104 * MiB;
constexpr size_t WS_UT = 176 * MiB;
constexpr size_t WS_YB = 192 * MiB;
constexpr size_t WS_KT = 224 * MiB;
constexpr size_t WS_MIX = 224 * MiB;
constexpr size_t WS_END = 256 * MiB;

struct Args { const float* in[29]; float* out; unsigned char* ws; int ph_lo, ph_hi; };

typedef __bf16 bf16x2_t __attribute__((ext_vector_type(2)));
__device__ __forceinline__ unsigned pkbf(float lo, float hi) { const f32x2 v = {lo, hi}; const bf16x2_t b = __builtin_convertvector(v, bf16x2_t); return __builtin_bit_cast(unsigned, b); }
__device__ __forceinline__ float bf2f(unsigned short b) { return __uint_as_float(((unsigned)b) << 16); }
__device__ __forceinline__ int opaque(int v) { asm volatile("" : "+v"(v)); return v; }
__device__ __forceinline__ float wave_sum(float v) {
#pragma unroll
    for (int o = 1; o < 64; o <<= 1) v += __shfl_xor(v, o);
    return v;
}

using pg8::Unit;
struct EpiSwiglu {
    static constexpr bool PERM = true, AFTER_DRAIN = false;
    bf16* H;
    __device__ __forceinline__ void operator()(const f32x4 (&acc)[2][2][4][2], const Unit& u, int wr, int wc, int fr, int fq) const {
        const int row0 = u.pm * 256 + wr * 64 + fr, col0 = u.pn * 128 + wc * 32 + 8 * fq;
#pragma unroll
        for (int ai = 0; ai < 2; ++ai)
#pragma unroll
            for (int m = 0; m < 4; ++m) {
                float o[8];
#pragma unroll
                for (int n = 0; n < 2; ++n)
#pragma unroll
                    for (int e = 0; e < 4; ++e) { const float a = acc[ai][0][m][n][e], b = acc[ai][1][m][n][e];
                        const float sg = __builtin_amdgcn_rcpf(1.0f + __builtin_amdgcn_exp2f(-1.4426950408889634f * a)); o[n * 4 + e] = a * sg * b; }
                u32x4 w; w.x = pkbf(o[0], o[1]); w.y = pkbf(o[2], o[3]); w.z = pkbf(o[4], o[5]); w.w = pkbf(o[6], o[7]);
                *(u32x4*)(H + (size_t)(row0 + ai * 128 + m * 16) * FF + col0) = w;
            }
    }
};
struct EpiResid {
    static constexpr bool PERM = false, AFTER_DRAIN = false;
    const float* resid; float* out; float s;
    __device__ __forceinline__ void operator()(const f32x4 (&acc)[2][2][4][2], const Unit& u, int wr, int wc, int fr, int fq) const {
        const int row0 = u.pm * 256 + wr * 64 + fr, col0 = u.pn * 256 + wc * 32 + 4 * fq;
#pragma unroll
        for (int ai = 0; ai < 2; ++ai)
#pragma unroll
            for (int m = 0; m < 4; ++m) { const size_t off = (size_t)(row0 + ai * 128 + m * 16) * D + col0;
#pragma unroll
                for (int bj = 0; bj < 2; ++bj)
#pragma unroll
                    for (int n = 0; n < 2; ++n) { const f32x4 rv = *(const f32x4*)(resid + off + bj * 128 + n * 16);
                        *(f32x4*)(out + off + bj * 128 + n * 16) = rv * ALPHA + acc[ai][bj][m][n] * s; } }
    }
};
struct EpiIn {
    static constexpr bool PERM = true, AFTER_DRAIN = false;
    bf16* Q; bf16* Kb; bf16* Vt; f16* uT;
    __device__ __forceinline__ void operator()(const f32x4 (&acc)[2][2][4][2], const Unit& u, int wr, int wc, int fr, int fq) const {
        const int row0 = u.pm * 256 + wr * 64 + fr;
        if (u.pn < 4) {
            bf16* base = (u.pn < 2) ? Q : Kb; const float sc = (u.pn < 2) ? 0.125f : 1.0f; const int col0 = (u.pn & 1) * 256 + wc * 32 + 8 * fq;
#pragma unroll
            for (int ai = 0; ai < 2; ++ai)
#pragma unroll
                for (int m = 0; m < 4; ++m)
#pragma unroll
                    for (int bj = 0; bj < 2; ++bj) { const f32x4 v0 = acc[ai][bj][m][0] * sc, v1 = acc[ai][bj][m][1] * sc;
                        u32x4 w; w.x = pkbf(v0[0], v0[1]); w.y = pkbf(v0[2], v0[3]); w.z = pkbf(v1[0], v1[1]); w.w = pkbf(v1[2], v1[3]);
                        *(u32x4*)(base + (size_t)(row0 + ai * 128 + m * 16) * 512 + col0 + bj * 128) = w; }
        } else if (u.pn < 6) {
            const int b = row0 >> 13, t0 = row0 & 8191, vc0 = (u.pn - 4) * 256 + wc * 32 + 8 * fq;
#pragma unroll
            for (int ai = 0; ai < 2; ++ai)
#pragma unroll
                for (int m = 0; m < 4; ++m)
#pragma unroll
                    for (int bj = 0; bj < 2; ++bj)
#pragma unroll
                        for (int n = 0; n < 2; ++n)
#pragma unroll
                            for (int e = 0; e < 4; ++e)
                                Vt[(((size_t)(b * 512 + vc0 + bj * 128 + n * 4 + e)) << 13) + t0 + ai * 128 + m * 16] = (bf16)(pkbf(acc[ai][bj][m][n][e], 0.f) & 0xffffu);
        } else {
            const int uc0 = (u.pn - 6) * 256 + wc * 32 + 8 * fq;
#pragma unroll
            for (int ai = 0; ai < 2; ++ai)
#pragma unroll
                for (int m = 0; m < 4; ++m)
#pragma unroll
                    for (int bj = 0; bj < 2; ++bj)
#pragma unroll
                        for (int n = 0; n < 2; ++n)
#pragma unroll
                            for (int e = 0; e < 4; ++e)
                                uT[(size_t)(uc0 + bj * 128 + n * 4 + e) * M + row0 + ai * 128 + m * 16] = (f16)acc[ai][bj][m][n][e];
        }
    }
};
struct EpiGate {
    static constexpr bool PERM = true, AFTER_DRAIN = false;
    bf16* G; const float* bg;
    __device__ __forceinline__ void operator()(const f32x4 (&acc)[2][2][4][2], const Unit& u, int wr, int wc, int fr, int fq) const {
        const int row0 = u.pm * 256 + wr * 64 + fr, col0 = u.pn * 256 + wc * 32 + 8 * fq;
#pragma unroll
        for (int bj = 0; bj < 2; ++bj) { const f32x4 b0 = *(const f32x4*)(bg + col0 + bj * 128), b1 = *(const f32x4*)(bg + col0 + bj * 128 + 4);
#pragma unroll
            for (int ai = 0; ai < 2; ++ai)
#pragma unroll
                for (int m = 0; m < 4; ++m) { float o[8];
#pragma unroll
                    for (int e = 0; e < 4; ++e) { o[e] = __builtin_amdgcn_rcpf(1.0f + __builtin_amdgcn_exp2f(-1.4426950408889634f * (acc[ai][bj][m][0][e] + b0[e])));
                                                  o[4 + e] = __builtin_amdgcn_rcpf(1.0f + __builtin_amdgcn_exp2f(-1.4426950408889634f * (acc[ai][bj][m][1][e] + b1[e]))); }
                    u32x4 w; w.x = pkbf(o[0], o[1]); w.y = pkbf(o[2], o[3]); w.z = pkbf(o[4], o[5]); w.w = pkbf(o[6], o[7]);
                    *(u32x4*)(G + (size_t)(row0 + ai * 128 + m * 16) * 2048 + col0 + bj * 128) = w; } }
    }
};
template <int SECOND> struct EpiMix {
    static constexpr bool PERM = true, AFTER_DRAIN = false;
    bf16* X; const bf16* G;
    __device__ __forceinline__ void operator()(const f32x4 (&acc)[2][2][4][2], const Unit& u, int wr, int wc, int fr, int fq) const {
        const int row0 = u.pm * 256 + wr * 64 + fr, col0 = u.pn * 256 + wc * 32 + 8 * fq;
#pragma unroll
        for (int ai = 0; ai < 2; ++ai)
#pragma unroll
            for (int m = 0; m < 4; ++m)
#pragma unroll
                for (int bj = 0; bj < 2; ++bj) { const size_t r = (size_t)(row0 + ai * 128 + m * 16);
                    const u32x4 g = *(const u32x4*)(G + r * 2048 + SECOND * 1024 + col0 + bj * 128);
                    u32x4 p = {0u, 0u, 0u, 0u}; if (SECOND) p = *(const u32x4*)(X + r * D + col0 + bj * 128);
                    float o[8];
#pragma unroll
                    for (int j = 0; j < 4; ++j) { const unsigned gw = g[j], pw = p[j]; const float a0 = acc[ai][bj][m][j >> 1][(j & 1) * 2], a1 = acc[ai][bj][m][j >> 1][(j & 1) * 2 + 1];
                        o[2 * j] = __uint_as_float(gw << 16) * a0 + __uint_as_float(pw << 16); o[2 * j + 1] = __uint_as_float(gw & 0xffff0000u) * a1 + __uint_as_float(pw & 0xffff0000u); }
                    u32x4 w; w.x = pkbf(o[0], o[1]); w.y = pkbf(o[2], o[3]); w.z = pkbf(o[4], o[5]); w.w = pkbf(o[6], o[7]);
                    *(u32x4*)(X + r * D + col0 + bj * 128) = w; }
    }
};
__device__ __forceinline__ void p0_transpose_item(const float* W, int K, int N, bf16* WT, int mode, int row_off, LAS float* scr, int item, int lane) {
    const int nblk = N / 32, kb = item / nblk, nb = item % nblk, k0 = 64 * kb, n0 = 32 * nb;
#pragma unroll 8
    for (int i = 0; i < 32; ++i) { const int kk = 2 * i + (lane >> 5); scr[kk * 33 + (lane & 31)] = W[(size_t)(k0 + kk) * N + n0 + (lane & 31)]; }
    asm volatile("s_waitcnt lgkmcnt(0)" ::: "memory");
    const int drow0 = mode ? ((n0 >> 7) * 256 + (n0 & 127) + row_off) : (row_off + n0);
    const int c = lane & 7;
#pragma unroll
    for (int j = 0; j < 4; ++j) { const int n = (lane >> 3) + 8 * j; const LAS float* s = scr + (8 * c) * 33 + n;
        u32x4 o; o.x = pkbf(s[0 * 33], s[1 * 33]); o.y = pkbf(s[2 * 33], s[3 * 33]); o.z = pkbf(s[4 * 33], s[5 * 33]); o.w = pkbf(s[6 * 33], s[7 * 33]);
        *(u32x4*)(WT + (size_t)(drow0 + n) * K + k0 + 8 * c) = o; }
    asm volatile("s_waitcnt lgkmcnt(0)" ::: "memory");
}

__device__ __forceinline__ void filter_tile(const Args& A, LAS unsigned char* lds, int tile, int tid) {
    const float* fw1 = A.in[11]; const float* fb1 = A.in[12]; const float* fw2 = A.in[13]; const float* fb2 = A.in[14];
    const float* fw3 = A.in[15]; const float* fb3 = A.in[16]; const float* freq = A.in[17];
    LAS float* zf = (LAS float*)lds;
    LAS float* h1 = zf + 33 * 33 + 3;
    LAS float* h2 = h1 + 33 * 64;
    const int t0 = tile * 32;
#pragma unroll 1
    for (int idx = tid; idx < 33 * 16; idx += NTHR) { const int tt = idx >> 4, f = idx & 15, i = t0 + tt;
        const float fj = 1e-4f + (float)f * ((15.0f - 1e-4f) / 15.0f), w = (6.283185307179586f / 8192.0f) * (float)i;
        const float s = __sinf(fj * w), c = __cosf(fj * w);
        zf[tt * 33 + 1 + f] = c; zf[tt * 33 + 17 + f] = -s; if (f == 0) zf[tt * 33] = (float)i * (1.0f / 8191.0f); }
    __syncthreads();
#pragma unroll 1
    for (int idx = tid; idx < 33 * 64; idx += NTHR) { const int tt = idx >> 6, o = idx & 63; float a = fb1[o];
#pragma unroll 1
        for (int f = 0; f < 33; ++f) a += zf[tt * 33 + f] * fw1[f * 64 + o];
        h1[tt * 64 + o] = __sinf(freq[o] * a); }
    __syncthreads();
#pragma unroll 1
    for (int idx = tid; idx < 33 * 64; idx += NTHR) { const int tt = idx >> 6, o = idx & 63; float a = fb2[o];
#pragma unroll 4
        for (int j = 0; j < 64; ++j) a += h1[tt * 64 + j] * fw2[j * 64 + o];
        h2[tt * 64 + o] = __sinf(freq[o] * a); }
    __syncthreads();
    const float dmin = 3.0701134573253945f, dmax = 15.350567286626973f;
    LAS f16* tl = (LAS f16*)(lds + 24576);
    float* part = (float*)(A.ws + WS_PART);
    f16* kT = (f16*)(A.ws + WS_KT);
#pragma unroll 1
    for (int dir = 0; dir < 2; ++dir) {
        const int col0 = dir * 1024 + tid * 2, c0 = col0 & 511;
        float acc[32][2];
#pragma unroll
        for (int tt = 0; tt < 32; ++tt) { acc[tt][0] = 0.f; acc[tt][1] = 0.f; }
        const LAS float* h2d = h2 + dir * 64;
#pragma unroll 1
        for (int j = 0; j < 64; j += 4) {
            const f32x2 w0 = *(const f32x2*)(fw3 + (size_t)(j + 0) * 2048 + col0), w1 = *(const f32x2*)(fw3 + (size_t)(j + 1) * 2048 + col0),
                        w2 = *(const f32x2*)(fw3 + (size_t)(j + 2) * 2048 + col0), w3 = *(const f32x2*)(fw3 + (size_t)(j + 3) * 2048 + col0);
#pragma unroll
            for (int tt = 0; tt < 32; ++tt) { const f32x4 hv = *(const LAS f32x4*)(h2d + tt * 64 + j);
#pragma unroll
                for (int c = 0; c < 2; ++c) acc[tt][c] += hv[0] * w0[c] + hv[1] * w1[c] + hv[2] * w2[c] + hv[3] * w3[c]; }
        }
        const f32x2 b3 = *(const f32x2*)(fb3 + col0);
        const float d0 = dmin + (float)(c0) * ((dmax - dmin) / 511.0f), d1 = dmin + (float)(c0 + 1) * ((dmax - dmin) / 511.0f);
        float ss0 = 0.f, ss1 = 0.f;
#pragma unroll
        for (int tt = 0; tt < 32; ++tt) { const int i = t0 + tt + dir; const float tl_ = (float)i * (1.0f / 8191.0f);
            float v0 = (acc[tt][0] + b3[0]) * __expf(-tl_ * d0), v1 = (acc[tt][1] + b3[1]) * __expf(-tl_ * d1); if (i >= 8192) { v0 = 0.f; v1 = 0.f; }
            ss0 += v0 * v0; ss1 += v1 * v1;
            tl[(tid * 2) * 34 + tt] = (f16)v0; tl[(tid * 2 + 1) * 34 + tt] = (f16)v1; }
        *(f32x2*)(part + (size_t)tile * 2048 + col0) = (f32x2){ss0, ss1};
        __syncthreads();
#pragma unroll 1
        for (int it = 0; it < 8; ++it) { const int chunk = it * NTHR + opaque(tid), row = chunk >> 2, p = chunk & 3;
            f16x8 o;
            if (dir == 0) {
#pragma unroll
                for (int e = 0; e < 8; ++e) o[e] = tl[row * 34 + p * 8 + e];
                *(f16x8*)(kT + (size_t)row * NFFT + t0 + p * 8) = o;
            } else {
#pragma unroll
                for (int e = 0; e < 8; ++e) o[e] = tl[row * 34 + 31 - p * 8 - e];
                *(f16x8*)(kT + (size_t)row * NFFT + (NFFT - t0 - 32) + p * 8) = o;
            }
        }
        __syncthreads();
    }
}

__device__ __forceinline__ void p0_prologue(const Args& A, LAS unsigned char* lds, int tid, int lane, int wave) {
    unsigned char* ws = A.ws;
    LAS float* scr = (LAS float*)(lds + wave * 16384);
    const int gw = blockIdx.x * NWAVES + wave, NGW = gridDim.x * NWAVES;
    constexpr int I_UP = (D / 64) * (FF / 32), I_DN = (FF / 64) * (D / 32), I_IN = (D / 64) * (5120 / 32), I_P = (512 / 64) * (D / 32), I_O = (D / 64) * (D / 32);
    constexpr int NITEMS = 6 * I_UP   + I_IN + 2 * I_P + I_O;
    static_assert(I_UP == I_DN, "item counts");
    for (int it = gw; it < NITEMS; it += NGW) {
        int r = it;
        if (r < I_UP) { p0_transpose_item(A.in[3], D, FF, (bf16*)(ws + WS_W13A), 1, 0, scr, r, lane); continue; } r -= I_UP;
        if (r < I_UP) { p0_transpose_item(A.in[4], D, FF, (bf16*)(ws + WS_W13A), 1, 128, scr, r, lane); continue; } r -= I_UP;
        if (r < I_DN) { p0_transpose_item(A.in[5], FF, D, (bf16*)(ws + WS_W2A), 0, 0, scr, r, lane); continue; } r -= I_DN;
        if (r < I_IN) { p0_transpose_item(A.in[6], D, 5120, (bf16*)(ws + WS_WIN), 0, 0, scr, r, lane); continue; } r -= I_IN;
        if (r < I_P) { p0_transpose_item(A.in[19], 512, D, (bf16*)(ws + WS_WPA), 0, 0, scr, r, lane); continue; } r -= I_P;
        if (r < I_P) { p0_transpose_item(A.in[20], 512, D, (bf16*)(ws + WS_WPB), 0, 0, scr, r, lane); continue; } r -= I_P;
        if (r < I_O) { p0_transpose_item(A.in[21], D, D, (bf16*)(ws + WS_WOUT), 0, 0, scr, r, lane); continue; } r -= I_O;
        if (r < I_UP) { p0_transpose_item(A.in[24], D, FF, (bf16*)(ws + WS_W13B), 1, 0, scr, r, lane); continue; } r -= I_UP;
        if (r < I_UP) { p0_transpose_item(A.in[25], D, FF, (bf16*)(ws + WS_W13B), 1, 128, scr, r, lane); continue; } r -= I_UP;
        p0_transpose_item(A.in[26], FF, D, (bf16*)(ws + WS_W2B), 0, 0, scr, r, lane);
    }
    { const f32x4* x4 = (const f32x4*)A.in[0]; u32x4* o4 = (u32x4*)(ws + WS_XB);
      for (size_t i = (size_t)blockIdx.x * NTHR + tid; i < (size_t)M * D / 8; i += (size_t)gridDim.x * NTHR) { const f32x4 a = x4[2 * i], b = x4[2 * i + 1];
          u32x4 w; w.x = pkbf(a[0], a[1]); w.y = pkbf(a[2], a[3]); w.z = pkbf(b[0], b[1]); w.w = pkbf(b[2], b[3]); o4[i] = w; } }
    __syncthreads();
    for (int pr = blockIdx.x; pr < 128; pr += gridDim.x) { filter_tile(A, lds, 2 * pr, tid); filter_tile(A, lds, 2 * pr + 1, tid); }
}

__device__ __forceinline__ void ln_phase(const float* src, float* dst, bf16* xb, const float* g, const float* b, int lane, int wave) {
    const int gw = blockIdx.x * NWAVES + wave, NGW = gridDim.x * NWAVES;
    f32x4 gv[4], bv[4];
#pragma unroll
    for (int j = 0; j < 4; ++j) { gv[j] = ((const f32x4*)g)[lane + 64 * j]; bv[j] = ((const f32x4*)b)[lane + 64 * j]; }
    for (int m = gw; m < M; m += NGW) {
        const f32x4* xr = (const f32x4*)(src + (size_t)m * D) + lane;
        f32x4 v[4]; float s = 0.f;
#pragma unroll
        for (int j = 0; j < 4; ++j) { v[j] = xr[64 * j]; s += (v[j][0] + v[j][1]) + (v[j][2] + v[j][3]); }
        const float mean = wave_sum(s) * (1.f / D); float s2 = 0.f;
#pragma unroll
        for (int j = 0; j < 4; ++j) { v[j] = v[j] - mean; s2 += (v[j][0] * v[j][0] + v[j][1] * v[j][1]) + (v[j][2] * v[j][2] + v[j][3] * v[j][3]); }
        const float rstd = 1.0f / sqrtf(wave_sum(s2) * (1.f / D) + LN_EPS);
        f32x4* orow = (f32x4*)(dst + (size_t)m * D) + lane;
#pragma unroll
        for (int j = 0; j < 4; ++j) { const f32x4 o = v[j] * rstd * gv[j] + bv[j]; orow[64 * j] = o;
            if (xb) { u32x2 w; w.x = pkbf(o[0], o[1]); w.y = pkbf(o[2], o[3]); ((u32x2*)(xb + (size_t)m * D))[lane + 64 * j] = w; } }
    }
}
typedef f32x2 cplx;
__device__ __forceinline__ cplx cmul(cplx a, cplx b) { return (cplx){a[0] * b[0] - a[1] * b[1], a[0] * b[1] + a[1] * b[0]}; }
__device__ __forceinline__ cplx cmulc(cplx a, cplx b) { return (cplx){a[0] * b[0] + a[1] * b[1], a[1] * b[0] - a[0] * b[1]}; }
__device__ __forceinline__ int swz(int i) { return i ^ ((i >> 5) & 3) ^ (((i >> 6) & 7) << 2); }
__device__ __forceinline__ cplx twd(const LAS cplx* T1, const LAS cplx* T2, int e) { return cmul(T1[e >> 7], T2[e & 127]); }
__device__ __forceinline__ void bfly_f(cplx& a0, cplx& a1, cplx& a2, cplx& a3) {
    const cplx t0 = a0 + a2, t1 = a0 - a2, t2 = a1 + a3, d = a1 - a3; const cplx t3 = (cplx){d[1], -d[0]};
    a0 = t0 + t2; a1 = t1 + t3; a2 = t0 - t2; a3 = t1 - t3;
}
__device__ __forceinline__ void bfly_i(cplx& a0, cplx& a1, cplx& a2, cplx& a3) {
    const cplx t0 = a0 + a2, t1 = a0 - a2, t2 = a1 + a3, d = a1 - a3; const cplx t3 = (cplx){-d[1], d[0]};
    a0 = t0 + t2; a1 = t1 + t3; a2 = t0 - t2; a3 = t1 - t3;
}
template <int LQ> __device__ __forceinline__ void fwd16(cplx (&r)[16], int j0, const LAS cplx* T1, const LAS cplx* T2) {
    constexpr int SA = 10 - LQ;
#pragma unroll
    for (int c = 0; c < 4; ++c) {
        bfly_f(r[c], r[c + 4], r[c + 8], r[c + 12]);
        const cplx w1 = twd(T1, T2, (j0 + (c << LQ)) << SA), w2 = cmul(w1, w1), w3 = cmul(w1, w2);
        r[c + 4] = cmul(r[c + 4], w1); r[c + 8] = cmul(r[c + 8], w2); r[c + 12] = cmul(r[c + 12], w3);
    }
    const cplx v1 = twd(T1, T2, j0 << (SA + 2)), v2 = cmul(v1, v1), v3 = cmul(v1, v2);
#pragma unroll
    for (int m = 0; m < 4; ++m) {
        bfly_f(r[4 * m], r[4 * m + 1], r[4 * m + 2], r[4 * m + 3]);
        r[4 * m + 1] = cmul(r[4 * m + 1], v1); r[4 * m + 2] = cmul(r[4 * m + 2], v2); r[4 * m + 3] = cmul(r[4 * m + 3], v3);
    }
}
template <int LQ> __device__ __forceinline__ void inv16(cplx (&r)[16], int j0, const LAS cplx* T1, const LAS cplx* T2) {
    constexpr int SA = 10 - LQ;
    const cplx v1 = twd(T1, T2, j0 << (SA + 2)), v2 = cmul(v1, v1), v3 = cmul(v1, v2);
#pragma unroll
    for (int m = 0; m < 4; ++m) {
        r[4 * m + 1] = cmulc(r[4 * m + 1], v1); r[4 * m + 2] = cmulc(r[4 * m + 2], v2); r[4 * m + 3] = cmulc(r[4 * m + 3], v3);
        bfly_i(r[4 * m], r[4 * m + 1], r[4 * m + 2], r[4 * m + 3]);
    }
#pragma unroll
    for (int c = 0; c < 4; ++c) {
        const cplx w1 = twd(T1, T2, (j0 + (c << LQ)) << SA), w2 = cmul(w1, w1), w3 = cmul(w1, w2);
        r[c + 4] = cmulc(r[c + 4], w1); r[c + 8] = cmulc(r[c + 8], w2); r[c + 12] = cmulc(r[c + 12], w3);
        bfly_i(r[c], r[c + 4], r[c + 8], r[c + 12]);
    }
}
template <int LQ, bool INV> __device__ __forceinline__ void lds_pass16(LAS cplx* Z, const LAS cplx* T1, const LAS cplx* T2, int tid) {
#pragma unroll 1
    for (int h = 0; h < 2; ++h) { const int s = opaque(tid) + h * NTHR, j0 = s & ((1 << LQ) - 1), g = (s >> LQ) << (LQ + 4);
        cplx r[16];
#pragma unroll
        for (int k = 0; k < 16; ++k) r[k] = Z[swz(g + j0 + (k << LQ))];
        if (INV) inv16<LQ>(r, j0, T1, T2); else fwd16<LQ>(r, j0, T1, T2);
#pragma unroll
        for (int k = 0; k < 16; ++k) Z[swz(g + j0 + (k << LQ))] = r[k];
    }
}
__device__ __forceinline__ float block_sum(float v, LAS float* red, int tid) {
    v = wave_sum(v); __syncthreads(); if ((tid & 63) == 0) red[tid >> 6] = v; __syncthreads();
    float s = 0.f;
#pragma unroll
    for (int i = 0; i < NWAVES; ++i) s += red[i];
    return s;
}
__device__ __forceinline__ float short_conv(const f16* uT, const float* sw, const float* sb, int ch, int b, int t) {
    const f16* p = uT + (size_t)ch * M + b * SEQ + t;
    const float um = t > 0 ? (float)p[-1] : 0.f, u0 = (float)p[0], up = t < SEQ - 1 ? (float)p[1] : 0.f;
    return sb[ch] + sw[ch] * um + sw[1536 + ch] * u0 + sw[3072 + ch] * up;
}

__device__ __forceinline__ void hyena_channel(const Args& A, LAS unsigned char* lds, int c, int tid) {
    LAS cplx* Z = (LAS cplx*)lds; const LAS cplx* T1 = (const LAS cplx*)(lds + 131072); const LAS cplx* T2 = T1 + 128; LAS float* red = (LAS float*)(lds + 131072 + 2048);
    f16* uT = (f16*)(A.ws + WS_UT); const f16* kT = (const f16*)(A.ws + WS_KT); const float* part = (const float*)(A.ws + WS_PART);
    const float* sw = A.in[9]; const float* sb = A.in[10]; const float* hb = A.in[18];
    unsigned long long* KC = (unsigned long long*)(A.ws + WS_KC) + (size_t)blockIdx.x * NFFT;
    float zr[2][8][2];
    { const float v_b = sb[c], v_w0 = sw[c], v_w1 = sw[1536 + c], v_w2 = sw[3072 + c];
#pragma unroll
    for (int h = 0; h < 2; ++h)
#pragma unroll
        for (int k = 0; k < 8; ++k) {
#pragma unroll
            for (int b = 0; b < 2; ++b) { const int t = tid + h * NTHR + 1024 * k; const f16* p = uT + (size_t)c * M + b * SEQ + t;
                const float um = t > 0 ? (float)p[-1] : 0.f, u0 = (float)p[0], up = t < SEQ - 1 ? (float)p[1] : 0.f;
                zr[h][k][b] = v_b + v_w0 * um + v_w1 * u0 + v_w2 * up; }
            if ((k & 1) == 1) __builtin_amdgcn_sched_barrier(0); } }
#pragma unroll 1
    for (int n = 0; n < 2; ++n) {
        const float ssq = block_sum(part[(size_t)(tid >> 1) * 2048 + (tid & 1) * 1024 + n * 512 + c], red, tid);
        const float kscale = 1.0f / sqrtf(ssq + 1e-12f);
        const f16* kr = kT + (size_t)(n * 512 + c) * NFFT;
#ifndef SK1
#pragma unroll 1
        for (int h = 0; h < 2; ++h) { const int j0 = opaque(tid) + h * NTHR; cplx r[16];
#pragma unroll
            for (int k = 0; k < 16; ++k) r[k] = (cplx){(float)kr[j0 + 1024 * k] * kscale, 0.f};
            fwd16<10>(r, j0, T1, T2);
#pragma unroll
            for (int k = 0; k < 16; ++k) Z[swz(j0 + 1024 * k)] = r[k]; }
#endif
        __syncthreads();
#ifndef SK2
        lds_pass16<6, false>(Z, T1, T2, tid); __syncthreads();
        lds_pass16<2, false>(Z, T1, T2, tid); __syncthreads();
#endif
#pragma unroll 1
        for (int it = 0; it < 8; ++it) { const int bf = it * NTHR + opaque(tid);
            cplx a0 = Z[swz(4 * bf)], a1 = Z[swz(4 * bf + 1)], a2 = Z[swz(4 * bf + 2)], a3 = Z[swz(4 * bf + 3)];
            bfly_f(a0, a1, a2, a3);
            f32x4* o = (f32x4*)(KC + 4 * bf); o[0] = (f32x4){a0[0], a0[1], a1[0], a1[1]}; o[1] = (f32x4){a2[0], a2[1], a3[0], a3[1]}; }
        asm volatile("s_waitcnt vmcnt(0)" ::: "memory");
        __syncthreads();
#pragma unroll 1
        for (int h = 0; h < 2; ++h) { const int j0 = opaque(tid) + h * NTHR; cplx r[16];
#pragma unroll
            for (int k = 0; k < 8; ++k) { r[k] = h ? (cplx){zr[1][k][0], zr[1][k][1]} : (cplx){zr[0][k][0], zr[0][k][1]}; r[k + 8] = (cplx){0.f, 0.f}; }
            fwd16<10>(r, j0, T1, T2);
#pragma unroll
            for (int k = 0; k < 16; ++k) Z[swz(j0 + 1024 * k)] = r[k];
            __builtin_amdgcn_sched_barrier(0); }
        __syncthreads();
        lds_pass16<6, false>(Z, T1, T2, tid); __syncthreads();
        lds_pass16<2, false>(Z, T1, T2, tid); __syncthreads();
#pragma unroll 1
        for (int it = 0; it < 8; ++it) { const int bf = it * NTHR + opaque(tid);
            cplx a0 = Z[swz(4 * bf)], a1 = Z[swz(4 * bf + 1)], a2 = Z[swz(4 * bf + 2)], a3 = Z[swz(4 * bf + 3)];
            bfly_f(a0, a1, a2, a3);
            unsigned long long k0 = __hip_atomic_load(KC + 4 * bf, __ATOMIC_RELAXED, __HIP_MEMORY_SCOPE_AGENT), k1 = __hip_atomic_load(KC + 4 * bf + 1, __ATOMIC_RELAXED, __HIP_MEMORY_SCOPE_AGENT),
                               k2 = __hip_atomic_load(KC + 4 * bf + 2, __ATOMIC_RELAXED, __HIP_MEMORY_SCOPE_AGENT), k3 = __hip_atomic_load(KC + 4 * bf + 3, __ATOMIC_RELAXED, __HIP_MEMORY_SCOPE_AGENT);
            a0 = cmul(a0, (cplx){__uint_as_float((unsigned)k0), __uint_as_float((unsigned)(k0 >> 32))});
            a1 = cmul(a1, (cplx){__uint_as_float((unsigned)k1), __uint_as_float((unsigned)(k1 >> 32))});
            a2 = cmul(a2, (cplx){__uint_as_float((unsigned)k2), __uint_as_float((unsigned)(k2 >> 32))});
            a3 = cmul(a3, (cplx){__uint_as_float((unsigned)k3), __uint_as_float((unsigned)(k3 >> 32))});
            bfly_i(a0, a1, a2, a3);
            Z[swz(4 * bf)] = a0; Z[swz(4 * bf + 1)] = a1; Z[swz(4 * bf + 2)] = a2; Z[swz(4 * bf + 3)] = a3; }
        __syncthreads();
        lds_pass16<2, true>(Z, T1, T2, tid); __syncthreads();
        lds_pass16<6, true>(Z, T1, T2, tid); __syncthreads();
        const float bias = hb[n * 512 + c];
        const int gch = (n + 1) * 512 + c;
        const float g_b = sb[gch], g_w0 = sw[gch], g_w1 = sw[1536 + gch], g_w2 = sw[3072 + gch];
#pragma unroll 1
        for (int h = 0; h < 2; ++h) { const int j0 = opaque(tid) + h * NTHR; cplx r[16];
#pragma unroll
            for (int k = 0; k < 16; ++k) r[k] = Z[swz(j0 + 1024 * k)];
            inv16<10>(r, j0, T1, T2);
            __builtin_amdgcn_sched_barrier(0);
#pragma unroll
            for (int k = 0; k < 8; ++k) {
#pragma unroll
                for (int b = 0; b < 2; ++b) { const int t = j0 + 1024 * k; const f16* p = uT + (size_t)gch * M + b * SEQ + t;
                    const float um = t > 0 ? (float)p[-1] : 0.f, u0 = (float)p[0], up = t < SEQ - 1 ? (float)p[1] : 0.f;
                    const float gate = g_b + g_w0 * um + g_w1 * u0 + g_w2 * up;
                    const float zo = h ? zr[1][k][b] : zr[0][k][b]; const float zn = gate * (r[k][b] * (1.0f / NFFT) + bias * zo);
                    if (h) zr[1][k][b] = zn; else zr[0][k][b] = zn; }
                if ((k & 1) == 1) __builtin_amdgcn_sched_barrier(0); }
        }
        __syncthreads();
    }
#pragma unroll
    for (int h = 0; h < 2; ++h)
#pragma unroll
        for (int k = 0; k < 8; ++k)
#pragma unroll
            for (int b = 0; b < 2; ++b) uT[(size_t)c * M + b * SEQ + tid + h * NTHR + 1024 * k] = (f16)zr[h][k][b];
}

__device__ __forceinline__ void na_unit(const Args& A, int u, int lane) {
    bf16* Q = (bf16*)(A.ws + WS_Q); const bf16* Kb = (const bf16*)(A.ws + WS_K); const bf16* Vt = (const bf16*)(A.ws + WS_VT); const float* rpb = A.in[8];
    const int jq = u & 3, r = (u >> 2) & 127, hh = (u >> 9) & 7, b = u >> 12, fr = lane & 15, fq = lane >> 4;
    const int rs = min(max(r - 4, 0), 120), wb = min(max(16 * jq - 8, 0), 32), c = 16 * jq + fr, cs = min(max(c - 8, 0), 48);
    const size_t qrow = (size_t)b * SEQ + r * 64 + c;
    const bf16x8 q0 = *(const bf16x8*)(Q + qrow * 512 + hh * 64 + 8 * fq), q1 = *(const bf16x8*)(Q + qrow * 512 + hh * 64 + 32 + 8 * fq);
    float s[8][2][4]; float mx = -1e30f;
#pragma unroll
    for (int a = 0; a < 8; ++a) { const int dr = rs + a - r + 7;
#pragma unroll
        for (int ct = 0; ct < 2; ++ct) { const size_t tok = (size_t)b * SEQ + (rs + a) * 64 + wb + 16 * ct + fr;
            const bf16x8 k0 = *(const bf16x8*)(Kb + tok * 512 + hh * 64 + 8 * fq), k1 = *(const bf16x8*)(Kb + tok * 512 + hh * 64 + 32 + 8 * fq);
            f32x4 acc = {0.f, 0.f, 0.f, 0.f};
            acc = __builtin_amdgcn_mfma_f32_16x16x32_bf16(k0, q0, acc, 0, 0, 0); acc = __builtin_amdgcn_mfma_f32_16x16x32_bf16(k1, q1, acc, 0, 0, 0);
#pragma unroll
            for (int i = 0; i < 4; ++i) { const int kc = wb + 16 * ct + 4 * fq + i; const bool ok = (kc >= cs) && (kc < cs + 16); const int dc = min(max(kc - c + 15, 0), 30);
                const float v = ok ? acc[i] + rpb[(hh * 15 + dr) * 31 + dc] : -1e30f; s[a][ct][i] = v; mx = fmaxf(mx, v); } } }
    mx = fmaxf(mx, __shfl_xor(mx, 16)); mx = fmaxf(mx, __shfl_xor(mx, 32));
    float sum = 0.f;
#pragma unroll
    for (int a = 0; a < 8; ++a)
#pragma unroll
        for (int ct = 0; ct < 2; ++ct)
#pragma unroll
            for (int i = 0; i < 4; ++i) { const float p = __expf(s[a][ct][i] - mx); s[a][ct][i] = p; sum += p; }
    sum += __shfl_xor(sum, 16); sum += __shfl_xor(sum, 32);
    const float inv = 1.0f / sum;
    f32x4 o[4];
#pragma unroll
    for (int dt = 0; dt < 4; ++dt) o[dt] = (f32x4){0.f, 0.f, 0.f, 0.f};
#pragma unroll
    for (int a = 0; a < 8; ++a) {
        u32x4 pw; pw.x = pkbf(s[a][0][0], s[a][0][1]); pw.y = pkbf(s[a][0][2], s[a][0][3]); pw.z = pkbf(s[a][1][0], s[a][1][1]); pw.w = pkbf(s[a][1][2], s[a][1][3]);
        const bf16x8 pb = __builtin_bit_cast(bf16x8, pw);
#pragma unroll
        for (int dt = 0; dt < 4; ++dt) { const bf16* vp = Vt + (((size_t)(b * 512 + hh * 64 + 16 * dt + fr)) << 13) + (rs + a) * 64 + wb + 4 * fq;
            const u32x2 lo = *(const u32x2*)vp, hi = *(const u32x2*)(vp + 16);
            const bf16x8 vf = __builtin_bit_cast(bf16x8, (u32x4){lo.x, lo.y, hi.x, hi.y});
            o[dt] = __builtin_amdgcn_mfma_f32_16x16x32_bf16(vf, pb, o[dt], 0, 0, 0); } }
#pragma unroll
    for (int dt = 0; dt < 4; ++dt) { u32x2 w; w.x = pkbf(o[dt][0] * inv, o[dt][1] * inv); w.y = pkbf(o[dt][2] * inv, o[dt][3] * inv);
        *(u32x2*)(Q + qrow * 512 + hh * 64 + 16 * dt + 4 * fq) = w; }
}

__device__ __forceinline__ void transpose_yb(const Args& A, LAS unsigned char* lds, int tid) {
    const f16* ybT = (const f16*)(A.ws + WS_UT); bf16* yb = (bf16*)(A.ws + WS_YB); LAS float* tl = (LAS float*)lds;
    for (int tile = blockIdx.x; tile < 8 * 256; tile += gridDim.x) { const int c0 = (tile & 7) * 64, k0 = (tile >> 3) * 64;
        { const int ci = tid >> 3, tj = (tid & 7) * 8; const f16x8 v = *(const f16x8*)(ybT + (size_t)(c0 + ci) * M + k0 + tj);
#pragma unroll
          for (int e = 0; e < 8; ++e) tl[ci * 65 + tj + e] = (float)v[e]; }
        __syncthreads();
        { const int ti = tid >> 3, cj = (tid & 7) * 8; float o[8];
#pragma unroll
          for (int e = 0; e < 8; ++e) o[e] = tl[(cj + e) * 65 + ti];
          u32x4 w; w.x = pkbf(o[0], o[1]); w.y = pkbf(o[2], o[3]); w.z = pkbf(o[4], o[5]); w.w = pkbf(o[6], o[7]);
          *(u32x4*)(yb + (size_t)(k0 + ti) * 512 + c0 + cj) = w; }
        __syncthreads();
    }
}
__global__ void __launch_bounds__(NTHR, 2) mk_fwd(Args A) {
    extern __shared__ __attribute__((aligned(16))) unsigned char lds_raw[];
    LAS unsigned char* lds = (LAS unsigned char*)lds_raw;
    const int tid = threadIdx.x, lane = tid & 63, wave = __builtin_amdgcn_readfirstlane(tid >> 6);
    cg::grid_group grid = cg::this_grid();
    const int lo = A.ph_lo, hi = A.ph_hi, G = gridDim.x, bx = blockIdx.x;
    unsigned char* ws = A.ws;
#ifndef PMASK
#define PMASK 0x3fff
#endif
#define IN(k) (((PMASK >> (k)) & 1) && ((lo <= (k) && (k) < hi) || ((k) == 13 && lo <= 6 && hi >= 8) || (lo == 13 && (k) == 13)))
#define GSYNC() do { __builtin_amdgcn_fence(__ATOMIC_RELEASE, "agent"); asm volatile("s_waitcnt vmcnt(0)" ::: "memory"); grid.sync(); __builtin_amdgcn_fence(__ATOMIC_ACQUIRE, "agent"); asm volatile("s_waitcnt vmcnt(0)" ::: "memory"); } while (0)
#define SEAM(k) do { if (IN(k) && IN((k) + 1)) GSYNC(); } while (0)
    bf16* XB = (bf16*)(ws + WS_XB); bf16* HB = (bf16*)(ws + WS_H); float* R = A.out;

    if (IN(0)) { p0_prologue(A, lds, tid, lane, wave); } SEAM(0);
    if (IN(1)) { pg8::Gemm g{XB, (const bf16*)(ws + WS_W13A), M, 2 * FF, D}; pg8::StaticOrder S; S.init(M, 2 * FF, G, bx); EpiSwiglu E{HB};
                 pg8::gemm_phase<EpiSwiglu, pg8::StaticOrder, true, true>(lds, g, S, E); } SEAM(1);
    if (IN(2)) { pg8::Gemm g{HB, (const bf16*)(ws + WS_W2A), M, D, FF}; pg8::StaticOrder S; S.init(M, D, G, bx); EpiResid E{A.in[0], R, 0.5f};
                 pg8::gemm_phase<EpiResid, pg8::StaticOrder, true, true>(lds, g, S, E); } SEAM(2);
    if (IN(3)) { ln_phase(R, R, XB, A.in[1], A.in[2], lane, wave); } SEAM(3);
    if (IN(4)) { pg8::Gemm g{XB, (const bf16*)(ws + WS_WIN), M, 3072, D}; pg8::StaticOrder S; S.init(M, 3072, G, bx);
                 EpiIn E{(bf16*)(ws + WS_Q), (bf16*)(ws + WS_K), (bf16*)(ws + WS_VT), (f16*)(ws + WS_UT)};
                 pg8::gemm_phase<EpiIn, pg8::StaticOrder, true, true>(lds, g, S, E); } SEAM(4);
    if (IN(5)) {
        if (tid < 256) { float s, c; const int k = tid & 127; sincospif(tid < 128 ? -(float)k * (1.0f / 64.0f) : -(float)k * (1.0f / 8192.0f), &s, &c);
            ((LAS cplx*)(lds + 131072))[tid] = (cplx){c, s}; }
        __syncthreads();
        #ifndef NO_HY
        for (int c = bx; c < 512; c += G) hyena_channel(A, lds, c, tid);
#endif
        #ifndef NO_NA
        for (int u = bx * NWAVES + wave; u < 8192; u += G * NWAVES) na_unit(A, u, lane);
#endif
    } SEAM(5);
    if (IN(6)) { transpose_yb(A, lds, tid); } SEAM(6);
    if (IN(13)) { pg8::Gemm g{XB, (const bf16*)(ws + WS_WIN) + (size_t)3072 * D, M, 2048, D}; pg8::StaticOrder S; S.init(M, 2048, G, bx); EpiGate E{(bf16*)(ws + WS_GATE), A.in[7]};
                  pg8::gemm_phase<EpiGate, pg8::StaticOrder, true, true>(lds, g, S, E); }
    if (IN(13) && IN(7)) GSYNC();
    if (IN(7)) { pg8::StaticOrder S; S.init(M, D, G, bx);
                 { pg8::Gemm g{(const bf16*)(ws + WS_Q), (const bf16*)(ws + WS_WPA), M, D, 512}; EpiMix<0> E{(bf16*)(ws + WS_MIX), (const bf16*)(ws + WS_GATE)};
                   pg8::gemm_phase<EpiMix<0>, pg8::StaticOrder, true, true>(lds, g, S, E); }
                 { pg8::Gemm g{(const bf16*)(ws + WS_YB), (const bf16*)(ws + WS_WPB), M, D, 512}; EpiMix<1> E{(bf16*)(ws + WS_MIX), (const bf16*)(ws + WS_GATE)};
                   pg8::gemm_phase<EpiMix<1>, pg8::StaticOrder, true, true>(lds, g, S, E); } } SEAM(7);
    if (IN(8)) { pg8::Gemm g{(const bf16*)(ws + WS_MIX), (const bf16*)(ws + WS_WOUT), M, D, D}; pg8::StaticOrder S; S.init(M, D, G, bx); EpiResid E{R, R, 1.0f};
                 pg8::gemm_phase<EpiResid, pg8::StaticOrder, true, true>(lds, g, S, E); } SEAM(8);
    if (IN(9)) { ln_phase(R, R, XB, A.in[22], A.in[23], lane, wave); } SEAM(9);
    if (IN(10)) { pg8::Gemm g{XB, (const bf16*)(ws + WS_W13B), M, 2 * FF, D}; pg8::StaticOrder S; S.init(M, 2 * FF, G, bx); EpiSwiglu E{HB};
                  pg8::gemm_phase<EpiSwiglu, pg8::StaticOrder, true, true>(lds, g, S, E); } SEAM(10);
    if (IN(11)) { pg8::Gemm g{HB, (const bf16*)(ws + WS_W2B), M, D, FF}; pg8::StaticOrder S; S.init(M, D, G, bx); EpiResid E{R, R, 0.5f};
                  pg8::gemm_phase<EpiResid, pg8::StaticOrder, true, true>(lds, g, S, E); } SEAM(11);
    if (IN(12)) { ln_phase(R, R, nullptr, A.in[27], A.in[28], lane, wave); }
#undef IN
#undef SEAM
}

extern "C" void kernel_launch(void* const* d_in, const int* in_sizes, int n_in, void* d_out, int out_size, void* d_ws, size_t ws_size, hipStream_t stream) {
    static int grid = 0;
    if (grid == 0) {
        if (n_in != 29 || in_sizes[0] != M * D || out_size != M * D || ws_size < WS_END) { fprintf(stderr, "kernel_launch: unexpected problem shape (n_in %d, ws %zu)\n", n_in, ws_size); grid = -1; return; }
        int dev = 0, cus = 0, per_cu = 0;
        (void)hipGetDevice(&dev); (void)hipDeviceGetAttribute(&cus, hipDeviceAttributeMultiprocessorCount, dev);
        if (hipFuncSetAttribute((const void*)mk_fwd, hipFuncAttributeMaxDynamicSharedMemorySize, LDS_BYTES) != hipSuccess) fprintf(stderr, "kernel_launch: hipFuncSetAttribute failed\n");
        if (hipOccupancyMaxActiveBlocksPerMultiprocessor(&per_cu, (const void*)mk_fwd, NTHR, LDS_BYTES) != hipSuccess || per_cu < 1) { fprintf(stderr, "kernel_launch: occupancy query says %d blocks per CU\n", per_cu); per_cu = 1; }
        (void)hipGetLastError();
        grid = cus * per_cu; if (grid > 256) grid = 256; if (grid < 1) grid = 1;
    }
    if (grid < 0) return;
    Args a{};
    for (int i = 0; i < 29; ++i) a.in[i] = (const float*)d_in[i];
    a.out = (float*)d_out; a.ws = (unsigned char*)d_ws;
#if MK_PER_PHASE
    const int order[14] = {0, 1, 2, 3, 4, 5, 6, 13, 7, 8, 9, 10, 11, 12};
    for (int i = 0; i < 14; ++i) { a.ph_lo = order[i]; a.ph_hi = order[i] + 1; hipLaunchKernelGGL(mk_fwd, dim3(grid), dim3(NTHR), LDS_BYTES, stream, a); }
#else
    a.ph_lo = 0; a.ph_hi = NPHASE;
    void* args[] = {&a};
    const hipError_t e = hipLaunchCooperativeKernel((const void*)mk_fwd, dim3(grid), dim3(NTHR), args, LDS_BYTES, stream);
    if (e != hipSuccess) fprintf(stderr, "kernel_launch: cooperative launch failed: %s (grid %d)\n", hipGetErrorString(e), grid);
#endif
}
```

```cpp
#include <hip/hip_runtime.h>
#include <hip/hip_cooperative_groups.h>
#include <cstdio>
#include <cstdint>
namespace cg = cooperative_groups;
namespace pg8 {
#define PG8_LAS __attribute__((address_space(3)))
typedef unsigned short bf16_t;
typedef short bf16x8 __attribute__((ext_vector_type(8)));
typedef float f32x4 __attribute__((ext_vector_type(4)));
typedef unsigned u32x4 __attribute__((ext_vector_type(4)));
constexpr int BM = 256, BK = 64, HALF = 128, HTB = HALF * BK * 2  , STAGE_BYTES = 8 * HTB, NXCD = 8, WGM = 8;

__host__ __device__ __forceinline__ int lds_byte(int r, int c) { const int st = (r >> 4) * 2 + (c >> 5), rr = r & 15, cc = c & 31, ob = rr * 64 + cc * 2; return st * 1024 + (ob ^ (((ob >> 9) & 1) << 5)); }
__host__ __device__ __forceinline__ void stage_rc(int b, int& R, int& C) { const int st = b / 1024, sb = b % 1024, swz = sb ^ (((sb >> 9) & 1) << 5); R = (st >> 1) * 16 + swz / 64; C = (st & 1) * 32 + (swz % 64) / 2; }
__host__ __device__ __forceinline__ int perm32(int rho) { const int n = rho >> 4, i = rho & 15; return 8 * (i >> 2) + 4 * n + (i & 3); }

struct Unit { int pm, pn; };
struct Gemm { const bf16_t* A; const bf16_t* Bt; int M, N, K; };

struct StaticOrder {
    int nM, nN, nwg, G, c;
    __host__ __device__ void init(int M, int N, int G_, int c_) { nM = M / BM; nN = N / BM; nwg = nM * nN; G = G_; c = c_; }
    __host__ __device__ bool next(int i, Unit& u) const {
        const long L = (long)i * G + c; if (L >= nwg) return false;
        int wgid = (int)L; { const int q = nwg / NXCD, r = nwg % NXCD, xcd = wgid % NXCD, off = wgid / NXCD; wgid = (xcd < r ? xcd * (q + 1) : r * (q + 1) + (xcd - r) * q) + off; }
        const int nig = WGM * nN, gid = wgid / nig, fm = gid * WGM, gsz = (nM - fm) < WGM ? (nM - fm) : WGM;
        u.pm = fm + ((wgid % nig) % gsz); u.pn = (wgid % nig) / gsz; return true;
    }
    __device__ __forceinline__ void a_ready(const Unit&) const {}
    __device__ __forceinline__ void done(const Unit&) const {}
};

__device__ __forceinline__ unsigned cvt_pk_bf16(float lo, float hi) { unsigned r; asm volatile("v_cvt_pk_bf16_f32 %0, %1, %2" : "=v"(r) : "v"(lo), "v"(hi)); return r; }
template <class Epi, class Sched, bool ALIGN_EPI = false, bool SP2 = false>
__device__ __forceinline__ void gemm_phase(PG8_LAS unsigned char* lds, const Gemm g, const Sched& S, const Epi& E) {
    const int tid = threadIdx.x, wid = __builtin_amdgcn_readfirstlane(tid >> 6), lane = tid & 63, wr = wid >> 2, wc = wid & 3, fr = lane & 15, fq = lane >> 4;
    const int K = g.K, nt = K / BK;
    unsigned voffA[2], voffB[2];
#pragma unroll
    for (int i = 0; i < 2; ++i) { int R, C; stage_rc(tid * 16 + i * 8192, R, C); const int Rb = Epi::PERM ? ((R & ~31) + perm32(R & 31)) : R;
        voffA[i] = (unsigned)(R * K + C) * 2u; voffB[i] = (unsigned)(Rb * K + C) * 2u; }
    const size_t kstep = (size_t)(BK * 2);
    const size_t hstep = (size_t)HALF * K * 2;
    const size_t tstep = 2 * hstep;
    const unsigned ldsw = (unsigned)wid * 1024u;
    const int aoff = lds_byte(wr * 64 + fr, fq * 8), boff = lds_byte(wc * 32 + fr, fq * 8);
#define PG8_SA(b, h) (((b) * 2 + (h)) * HTB)
#define PG8_SB(b, h) ((4 + (b) * 2 + (h)) * HTB)
#define PG8_STAGE(bufoff, gbase, voff) do { _Pragma("unroll") for (int _i = 0; _i < 2; ++_i) \
        __builtin_amdgcn_global_load_lds((const unsigned*)((const char*)(gbase) + (voff)[_i]), (PG8_LAS unsigned*)(lds + (bufoff) + ldsw + _i * 8192), 16, 0, 0); } while (0)
#define PG8_LDA(dst, b, h) do { _Pragma("unroll") for (int m = 0; m < 4; ++m) _Pragma("unroll") for (int k = 0; k < 2; ++k) dst[m][k] = *(const PG8_LAS bf16x8*)(lds + PG8_SA(b, h) + aoff + m * 2048 + k * 1024); } while (0)
#define PG8_LDB(dst, b, h) do { _Pragma("unroll") for (int n = 0; n < 2; ++n) _Pragma("unroll") for (int k = 0; k < 2; ++k) dst[n][k] = *(const PG8_LAS bf16x8*)(lds + PG8_SB(b, h) + boff + n * 2048 + k * 1024); } while (0)
#define PG8_MMA(ai, bj, At, Bt) do { __builtin_amdgcn_s_setprio(1); _Pragma("unroll") for (int m = 0; m < 4; ++m) _Pragma("unroll") for (int n = 0; n < 2; ++n) _Pragma("unroll") for (int k = 0; k < 2; ++k) \
        acc[ai][bj][m][n] = __builtin_amdgcn_mfma_f32_16x16x32_bf16(Bt[n][k], At[m][k], acc[ai][bj][m][n], 0, 0, 0); __builtin_amdgcn_s_setprio(0); } while (0)
#define PG8_WAIT_V(n) asm volatile("s_waitcnt vmcnt(" #n ")" ::: "memory")
#define PG8_WAIT_L(n) asm volatile("s_waitcnt lgkmcnt(" #n ")" ::: "memory")
#define PG8_BAR __builtin_amdgcn_s_barrier()
#define PG8_SCHED __builtin_amdgcn_sched_barrier(0)
    Unit cur, nxt; int ui = 0;
    if (!S.next(0, cur)) return;
    f32x4 acc[2][2][4][2];
#pragma unroll
    for (int a = 0; a < 2; ++a)
#pragma unroll
        for (int b = 0; b < 2; ++b)
#pragma unroll
            for (int m = 0; m < 4; ++m)
#pragma unroll
                for (int n = 0; n < 2; ++n) acc[a][b][m][n] = (f32x4){0.f, 0.f, 0.f, 0.f};
    bf16x8 At[4][2], B0[2][2], B1[2][2];
    const char* cA = (const char*)g.A + (size_t)cur.pm * tstep; const char* cB = (const char*)g.Bt + (size_t)cur.pn * tstep;
    S.a_ready(cur);
    if constexpr (SP2) {
        PG8_STAGE(PG8_SB(0, 0), cB, voffB); PG8_STAGE(PG8_SB(0, 1), cB + hstep, voffB); PG8_STAGE(PG8_SA(0, 0), cA, voffA); PG8_STAGE(PG8_SA(0, 1), cA + hstep, voffA);
        if (wr == 1) PG8_BAR;
        PG8_WAIT_V(2); PG8_BAR;
        PG8_STAGE(PG8_SB(1, 0), cB + kstep, voffB); PG8_STAGE(PG8_SA(1, 0), cA + kstep, voffA); PG8_STAGE(PG8_SB(1, 1), cB + hstep + kstep, voffB);
        PG8_WAIT_V(6); PG8_BAR;
    } else {
        PG8_STAGE(PG8_SB(0, 0), cB, voffB); PG8_STAGE(PG8_SA(0, 0), cA, voffA); PG8_STAGE(PG8_SB(0, 1), cB + hstep, voffB); PG8_STAGE(PG8_SA(0, 1), cA + hstep, voffA);
        if (wr == 1) PG8_BAR;
        PG8_WAIT_V(4); PG8_BAR;
        PG8_STAGE(PG8_SB(1, 0), cB + kstep, voffB); PG8_STAGE(PG8_SA(1, 0), cA + kstep, voffA); PG8_STAGE(PG8_SB(1, 1), cB + hstep + kstep, voffB);
        PG8_WAIT_V(6); PG8_BAR;
    }
    for (;;) {
        const bool has_next = S.next(ui + 1, nxt);
        const char* nA = has_next ? (const char*)g.A + (size_t)nxt.pm * tstep : cA; const char* nB = has_next ? (const char*)g.Bt + (size_t)nxt.pn * tstep : cB;
        for (int t = 0; t < nt; t += 2) {
            const bool last = (t == nt - 2);
            const char* a1 = cA + (size_t)(t + 1) * kstep;
            const char* a2 = last ? nA : cA + (size_t)(t + 2) * kstep; const char* b2 = last ? nB : cB + (size_t)(t + 2) * kstep;
            const char* a3 = a2 + kstep; const char* b3 = b2 + kstep;
            if (last && has_next) S.a_ready(nxt);
            if constexpr (SP2) {
            PG8_LDB(B0, 0, 0); PG8_LDB(B1, 0, 1); PG8_SCHED; PG8_LDA(At, 0, 0); PG8_STAGE(PG8_SA(1, 1), a1 + hstep, voffA);
            PG8_WAIT_V(8); PG8_WAIT_L(0); PG8_BAR; PG8_MMA(0, 0, At, B0); PG8_MMA(0, 1, At, B1); PG8_BAR; PG8_SCHED;
            PG8_LDA(At, 0, 1); PG8_STAGE(PG8_SB(0, 0), b2, voffB); PG8_STAGE(PG8_SB(0, 1), b2 + hstep, voffB); PG8_STAGE(PG8_SA(0, 0), a2, voffA);
            PG8_WAIT_V(8); PG8_WAIT_L(0); PG8_BAR; PG8_MMA(1, 0, At, B0); PG8_MMA(1, 1, At, B1); PG8_BAR; PG8_SCHED;
            PG8_LDB(B0, 1, 0); PG8_LDB(B1, 1, 1); PG8_SCHED; PG8_LDA(At, 1, 0); PG8_STAGE(PG8_SA(0, 1), a2 + hstep, voffA);
            PG8_WAIT_V(8); PG8_WAIT_L(0); PG8_BAR; PG8_MMA(0, 0, At, B0); PG8_MMA(0, 1, At, B1); PG8_BAR; PG8_SCHED;
            PG8_LDA(At, 1, 1); PG8_STAGE(PG8_SB(1, 0), b3, voffB); PG8_STAGE(PG8_SB(1, 1), b3 + hstep, voffB); PG8_STAGE(PG8_SA(1, 0), a3, voffA);
            PG8_WAIT_V(8); PG8_WAIT_L(0); PG8_BAR; PG8_MMA(1, 0, At, B0); PG8_MMA(1, 1, At, B1); PG8_BAR; PG8_SCHED;
            } else {
            PG8_LDB(B0, 0, 0); PG8_SCHED; PG8_LDA(At, 0, 0); PG8_STAGE(PG8_SA(1, 1), a1 + hstep, voffA);
            PG8_WAIT_L(8); PG8_BAR; PG8_WAIT_L(0); PG8_MMA(0, 0, At, B0); PG8_BAR; PG8_SCHED;
            PG8_LDB(B1, 0, 1); PG8_STAGE(PG8_SB(0, 0), b2, voffB);
            PG8_BAR; PG8_WAIT_L(0); PG8_MMA(0, 1, At, B1); PG8_BAR;
            PG8_LDA(At, 0, 1); PG8_STAGE(PG8_SA(0, 0), a2, voffA);
            PG8_BAR; PG8_WAIT_L(0); PG8_MMA(1, 0, At, B0); PG8_BAR; PG8_SCHED;
            PG8_STAGE(PG8_SB(0, 1), b2 + hstep, voffB);
            PG8_WAIT_V(6); PG8_BAR; PG8_MMA(1, 1, At, B1); PG8_BAR;
            PG8_LDB(B0, 1, 0); PG8_SCHED; PG8_LDA(At, 1, 0); PG8_STAGE(PG8_SA(0, 1), a2 + hstep, voffA);
            PG8_WAIT_L(8); PG8_BAR; PG8_WAIT_L(0); PG8_MMA(0, 0, At, B0); PG8_BAR; PG8_SCHED;
            PG8_LDB(B1, 1, 1); PG8_STAGE(PG8_SB(1, 0), b3, voffB);
            PG8_BAR; PG8_WAIT_L(0); PG8_MMA(0, 1, At, B1); PG8_BAR;
            PG8_LDA(At, 1, 1); PG8_STAGE(PG8_SA(1, 0), a3, voffA);
            PG8_BAR; PG8_WAIT_L(0); PG8_MMA(1, 0, At, B0); PG8_BAR; PG8_SCHED;
            PG8_STAGE(PG8_SB(1, 1), b3 + hstep, voffB);
            PG8_WAIT_V(6); PG8_BAR; PG8_MMA(1, 1, At, B1); PG8_BAR;
            }
        }
        if constexpr (ALIGN_EPI) { if (wr == 0) PG8_BAR; }
        if constexpr (!Epi::AFTER_DRAIN) { E(acc, cur, wr, wc, fr, fq); S.done(cur); }
        if (!has_next) break;
#pragma unroll
        for (int a = 0; a < 2; ++a)
#pragma unroll
            for (int b = 0; b < 2; ++b)
#pragma unroll
                for (int m = 0; m < 4; ++m)
#pragma unroll
                    for (int n = 0; n < 2; ++n) acc[a][b][m][n] = (f32x4){0.f, 0.f, 0.f, 0.f};
        cur = nxt; cA = nA; cB = nB; ++ui;
        if constexpr (ALIGN_EPI) { if (wr == 1) PG8_BAR; }
    }
    PG8_WAIT_V(0);
    if constexpr (!ALIGN_EPI) { if (wr == 0) PG8_BAR; }
    PG8_BAR;
    if constexpr (Epi::AFTER_DRAIN) { E.fused(acc, cur, wr, wc, fr, fq, lds, wid, lane); S.done(cur); }
#undef PG8_SA
#undef PG8_SB
#undef PG8_STAGE
#undef PG8_LDA
#undef PG8_LDB
#undef PG8_MMA
#undef PG8_WAIT_V
#undef PG8_WAIT_L
#undef PG8_BAR
#undef PG8_SCHED
}
}
#ifndef MK_PER_PHASE
#define MK_PER_PHASE 0
#endif
#define LAS __attribute__((address_space(3)))
typedef unsigned short bf16;
typedef _Float16 f16;
typedef float f32x4 __attribute__((ext_vector_type(4)));
typedef float f32x2 __attribute__((ext_vector_type(2)));
typedef short bf16x8 __attribute__((ext_vector_type(8)));
typedef unsigned u32x4 __attribute__((ext_vector_type(4)));
typedef unsigned u32x2 __attribute__((ext_vector_type(2)));
typedef _Float16 f16x8 __attribute__((ext_vector_type(8)));

constexpr int M = 16384, D = 1024, FF = 2816, SEQ = 8192, NFFT = 16384;
constexpr float ALPHA = 1.1892071150027210667f;
constexpr float LN_EPS = 1e-5f;
constexpr int NTHR = 512, NWAVES = 8;
constexpr int LDS_BYTES = 147456;
constexpr int NPHASE = 13;

constexpr size_t MiB = 1u << 20;
constexpr size_t WS_PART = 1 * MiB;
constexpr size_t WS_W13A = 8 * MiB, WS_W2A = 19 * MiB, WS_WIN = 25 * MiB, WS_WPA = 35 * MiB, WS_WPB = 36 * MiB, WS_WOUT = 37 * MiB, WS_W13B = 39 * MiB, WS_W2B = 50 * MiB;
constexpr size_t WS_XB = 56 * MiB;
constexpr size_t WS_H = 88 * MiB;
constexpr size_t WS_Q = 88 * MiB, WS_K = 104 * MiB, WS_VT = 120 * MiB, WS_KC = 136 * MiB;
constexpr size_t WS_GATE = 104 * MiB;
constexpr size_t WS_UT = 176 * MiB;
constexpr size_t WS_YB = 192 * MiB;
constexpr size_t WS_KT = 224 * MiB;
constexpr size_t WS_MIX = 224 * MiB;
constexpr size_t WS_END = 256 * MiB;

struct Args { const float* in[29]; float* out; unsigned char* ws; int ph_lo, ph_hi; };

typedef __bf16 bf16x2_t __attribute__((ext_vector_type(2)));
__device__ __forceinline__ unsigned pkbf(float lo, float hi) { const f32x2 v = {lo, hi}; const bf16x2_t b = __builtin_convertvector(v, bf16x2_t); return __builtin_bit_cast(unsigned, b); }
__device__ __forceinline__ float bf2f(unsigned short b) { return __uint_as_float(((unsigned)b) << 16); }
__device__ __forceinline__ int opaque(int v) { asm volatile("" : "+v"(v)); return v; }
__device__ __forceinline__ float wave_sum(float v) {
#pragma unroll
    for (int o = 1; o < 64; o <<= 1) v += __shfl_xor(v, o);
    return v;
}

using pg8::Unit;
struct EpiSwiglu {
    static constexpr bool PERM = true, AFTER_DRAIN = false;
    bf16* H;
    __device__ __forceinline__ void operator()(const f32x4 (&acc)[2][2][4][2], const Unit& u, int wr, int wc, int fr, int fq) const {
        const int row0 = u.pm * 256 + wr * 64 + fr, col0 = u.pn * 128 + wc * 32 + 8 * fq;
#pragma unroll
        for (int ai = 0; ai < 2; ++ai)
#pragma unroll
            for (int m = 0; m < 4; ++m) {
                float o[8];
#pragma unroll
                for (int n = 0; n < 2; ++n)
#pragma unroll
                    for (int e = 0; e < 4; ++e) { const float a = acc[ai][0][m][n][e], b = acc[ai][1][m][n][e];
                        const float sg = __builtin_amdgcn_rcpf(1.0f + __builtin_amdgcn_exp2f(-1.4426950408889634f * a)); o[n * 4 + e] = a * sg * b; }
                u32x4 w; w.x = pkbf(o[0], o[1]); w.y = pkbf(o[2], o[3]); w.z = pkbf(o[4], o[5]); w.w = pkbf(o[6], o[7]);
                *(u32x4*)(H + (size_t)(row0 + ai * 128 + m * 16) * FF + col0) = w;
            }
    }
};
struct EpiResid {
    static constexpr bool PERM = false, AFTER_DRAIN = false;
    const float* resid; float* out; float s;
    __device__ __forceinline__ void operator()(const f32x4 (&acc)[2][2][4][2], const Unit& u, int wr, int wc, int fr, int fq) const {
        const int row0 = u.pm * 256 + wr * 64 + fr, col0 = u.pn * 256 + wc * 32 + 4 * fq;
#pragma unroll
        for (int ai = 0; ai < 2; ++ai)
#pragma unroll
            for (int m = 0; m < 4; ++m) { const size_t off = (size_t)(row0 + ai * 128 + m * 16) * D + col0;
#pragma unroll
                for (int bj = 0; bj < 2; ++bj)
#pragma unroll
                    for (int n = 0; n < 2; ++n) { const f32x4 rv = *(const f32x4*)(resid + off + bj * 128 + n * 16);
                        *(f32x4*)(out + off + bj * 128 + n * 16) = rv * ALPHA + acc[ai][bj][m][n] * s; } }
    }
};
struct EpiIn {
    static constexpr bool PERM = true, AFTER_DRAIN = false;
    bf16* Q; bf16* Kb; bf16* Vt; f16* uT;
    __device__ __forceinline__ void operator()(const f32x4 (&acc)[2][2][4][2], const Unit& u, int wr, int wc, int fr, int fq) const {
        const int row0 = u.pm * 256 + wr * 64 + fr;
        if (u.pn < 4) {
            bf16* base = (u.pn < 2) ? Q : Kb; const float sc = (u.pn < 2) ? 0.125f : 1.0f; const int col0 = (u.pn & 1) * 256 + wc * 32 + 8 * fq;
#pragma unroll
            for (int ai = 0; ai < 2; ++ai)
#pragma unroll
                for (int m = 0; m < 4; ++m)
#pragma unroll
                    for (int bj = 0; bj < 2; ++bj) { const f32x4 v0 = acc[ai][bj][m][0] * sc, v1 = acc[ai][bj][m][1] * sc;
                        u32x4 w; w.x = pkbf(v0[0], v0[1]); w.y = pkbf(v0[2], v0[3]); w.z = pkbf(v1[0], v1[1]); w.w = pkbf(v1[2], v1[3]);
                        *(u32x4*)(base + (size_t)(row0 + ai * 128 + m * 16) * 512 + col0 + bj * 128) = w; }
        } else if (u.pn < 6) {
            const int b = row0 >> 13, t0 = row0 & 8191, vc0 = (u.pn - 4) * 256 + wc * 32 + 8 * fq;
#pragma unroll
            for (int ai = 0; ai < 2; ++ai)
#pragma unroll
                for (int m = 0; m < 4; ++m)
#pragma unroll
                    for (int bj = 0; bj < 2; ++bj)
#pragma unroll
                        for (int n = 0; n < 2; ++n)
#pragma unroll
                            for (int e = 0; e < 4; ++e)
                                Vt[(((size_t)(b * 512 + vc0 + bj * 128 + n * 4 + e)) << 13) + t0 + ai * 128 + m * 16] = (bf16)(pkbf(acc[ai][bj][m][n][e], 0.f) & 0xffffu);
        } else {
            const int uc0 = (u.pn - 6) * 256 + wc * 32 + 8 * fq;
#pragma unroll
            for (int ai = 0; ai < 2; ++ai)
#pragma unroll
                for (int m = 0; m < 4; ++m)
#pragma unroll
                    for (int bj = 0; bj < 2; ++bj)
#pragma unroll
                        for (int n = 0; n < 2; ++n)
#pragma unroll
                            for (int e = 0; e < 4; ++e)
                                uT[(size_t)(uc0 + bj * 128 + n * 4 + e) * M + row0 + ai * 128 + m * 16] = (f16)acc[ai][bj][m][n][e];
        }
    }
};
struct EpiGate {
    static constexpr bool PERM = true, AFTER_DRAIN = false;
    bf16* G; const float* bg;
    __device__ __forceinline__ void operator()(const f32x4 (&acc)[2][2][4][2], const Unit& u, int wr, int wc, int fr, int fq) const {
        const int row0 = u.pm * 256 + wr * 64 + fr, col0 = u.pn * 256 + wc * 32 + 8 * fq;
#pragma unroll
        for (int bj = 0; bj < 2; ++bj) { const f32x4 b0 = *(const f32x4*)(bg + col0 + bj * 128), b1 = *(const f32x4*)(bg + col0 + bj * 128 + 4);
#pragma unroll
            for (int ai = 0; ai < 2; ++ai)
#pragma unroll
                for (int m = 0; m < 4; ++m) { float o[8];
#pragma unroll
                    for (int e = 0; e < 4; ++e) { o[e] = __builtin_amdgcn_rcpf(1.0f + __builtin_amdgcn_exp2f(-1.4426950408889634f * (acc[ai][bj][m][0][e] + b0[e])));
                                                  o[4 + e] = __builtin_amdgcn_rcpf(1.0f + __builtin_amdgcn_exp2f(-1.4426950408889634f * (acc[ai][bj][m][1][e] + b1[e]))); }
                    u32x4 w; w.x = pkbf(o[0], o[1]); w.y = pkbf(o[2], o[3]); w.z = pkbf(o[4], o[5]); w.w = pkbf(o[6], o[7]);
                    *(u32x4*)(G + (size_t)(row0 + ai * 128 + m * 16) * 2048 + col0 + bj * 128) = w; } }
    }
};
template <int SECOND> struct EpiMix {
    static constexpr bool PERM = true, AFTER_DRAIN = false;
    bf16* X; const bf16* G;
    __device__ __forceinline__ void operator()(const f32x4 (&acc)[2][2][4][2], const Unit& u, int wr, int wc, int fr, int fq) const {
        const int row0 = u.pm * 256 + wr * 64 + fr, col0 = u.pn * 256 + wc * 32 + 8 * fq;
#pragma unroll
        for (int ai = 0; ai < 2; ++ai)
#pragma unroll
            for (int m = 0; m < 4; ++m)
#pragma unroll
                for (int bj = 0; bj < 2; ++bj) { const size_t r = (size_t)(row0 + ai * 128 + m * 16);
                    const u32x4 g = *(const u32x4*)(G + r * 2048 + SECOND * 1024 + col0 + bj * 128);
                    u32x4 p = {0u, 0u, 0u, 0u}; if (SECOND) p = *(const u32x4*)(X + r * D + col0 + bj * 128);
                    float o[8];
#pragma unroll
                    for (int j = 0; j < 4; ++j) { const unsigned gw = g[j], pw = p[j]; const float a0 = acc[ai][bj][m][j >> 1][(j & 1) * 2], a1 = acc[ai][bj][m][j >> 1][(j & 1) * 2 + 1];
                        o[2 * j] = __uint_as_float(gw << 16) * a0 + __uint_as_float(pw << 16); o[2 * j + 1] = __uint_as_float(gw & 0xffff0000u) * a1 + __uint_as_float(pw & 0xffff0000u); }
                    u32x4 w; w.x = pkbf(o[0], o[1]); w.y = pkbf(o[2], o[3]); w.z = pkbf(o[4], o[5]); w.w = pkbf(o[6], o[7]);
                    *(u32x4*)(X + r * D + col0 + bj * 128) = w; }
    }
};
__device__ __forceinline__ void p0_transpose_item(const float* W, int K, int N, bf16* WT, int mode, int row_off, LAS float* scr, int item, int lane) {
    const int nblk = N / 32, kb = item / nblk, nb = item % nblk, k0 = 64 * kb, n0 = 32 * nb;
#pragma unroll 8
    for (int i = 0; i < 32; ++i) { const int kk = 2 * i + (lane >> 5); scr[kk * 33 + (lane & 31)] = W[(size_t)(k0 + kk) * N + n0 + (lane & 31)]; }
    asm volatile("s_waitcnt lgkmcnt(0)" ::: "memory");
    const int drow0 = mode ? ((n0 >> 7) * 256 + (n0 & 127) + row_off) : (row_off + n0);
    const int c = lane & 7;
#pragma unroll
    for (int j = 0; j < 4; ++j) { const int n = (lane >> 3) + 8 * j; const LAS float* s = scr + (8 * c) * 33 + n;
        u32x4 o; o.x = pkbf(s[0 * 33], s[1 * 33]); o.y = pkbf(s[2 * 33], s[3 * 33]); o.z = pkbf(s[4 * 33], s[5 * 33]); o.w = pkbf(s[6 * 33], s[7 * 33]);
        *(u32x4*)(WT + (size_t)(drow0 + n) * K + k0 + 8 * c) = o; }
    asm volatile("s_waitcnt lgkmcnt(0)" ::: "memory");
}

__device__ __forceinline__ void filter_tile(const Args& A, LAS unsigned char* lds, int tile, int tid) {
    const float* fw1 = A.in[11]; const float* fb1 = A.in[12]; const float* fw2 = A.in[13]; const float* fb2 = A.in[14];
    const float* fw3 = A.in[15]; const float* fb3 = A.in[16]; const float* freq = A.in[17];
    LAS float* zf = (LAS float*)lds;
    LAS float* h1 = zf + 33 * 33 + 3;
    LAS float* h2 = h1 + 33 * 64;
    const int t0 = tile * 32;
#pragma unroll 1
    for (int idx = tid; idx < 33 * 16; idx += NTHR) { const int tt = idx >> 4, f = idx & 15, i = t0 + tt;
        const float fj = 1e-4f + (float)f * ((15.0f - 1e-4f) / 15.0f), w = (6.283185307179586f / 8192.0f) * (float)i;
        const float s = __sinf(fj * w), c = __cosf(fj * w);
        zf[tt * 33 + 1 + f] = c; zf[tt * 33 + 17 + f] = -s; if (f == 0) zf[tt * 33] = (float)i * (1.0f / 8191.0f); }
    __syncthreads();
#pragma unroll 1
    for (int idx = tid; idx < 33 * 64; idx += NTHR) { const int tt = idx >> 6, o = idx & 63; float a = fb1[o];
#pragma unroll 1
        for (int f = 0; f < 33; ++f) a += zf[tt * 33 + f] * fw1[f * 64 + o];
        h1[tt * 64 + o] = __sinf(freq[o] * a); }
    __syncthreads();
#pragma unroll 1
    for (int idx = tid; idx < 33 * 64; idx += NTHR) { const int tt = idx >> 6, o = idx & 63; float a = fb2[o];
#pragma unroll 4
        for (int j = 0; j < 64; ++j) a += h1[tt * 64 + j] * fw2[j * 64 + o];
        h2[tt * 64 + o] = __sinf(freq[o] * a); }
    __syncthreads();
    const float dmin = 3.0701134573253945f, dmax = 15.350567286626973f;
    LAS f16* tl = (LAS f16*)(lds + 24576);
    float* part = (float*)(A.ws + WS_PART);
    f16* kT = (f16*)(A.ws + WS_KT);
#pragma unroll 1
    for (int dir = 0; dir < 2; ++dir) {
        const int col0 = dir * 1024 + tid * 2, c0 = col0 & 511;
        float acc[32][2];
#pragma unroll
        for (int tt = 0; tt < 32; ++tt) { acc[tt][0] = 0.f; acc[tt][1] = 0.f; }
        const LAS float* h2d = h2 + dir * 64;
#pragma unroll 1
        for (int j = 0; j < 64; j += 4) {
            const f32x2 w0 = *(const f32x2*)(fw3 + (size_t)(j + 0) * 2048 + col0), w1 = *(const f32x2*)(fw3 + (size_t)(j + 1) * 2048 + col0),
                        w2 = *(const f32x2*)(fw3 + (size_t)(j + 2) * 2048 + col0), w3 = *(const f32x2*)(fw3 + (size_t)(j + 3) * 2048 + col0);
#pragma unroll
            for (int tt = 0; tt < 32; ++tt) { const f32x4 hv = *(const LAS f32x4*)(h2d + tt * 64 + j);
#pragma unroll
                for (int c = 0; c < 2; ++c) acc[tt][c] += hv[0] * w0[c] + hv[1] * w1[c] + hv[2] * w2[c] + hv[3] * w3[c]; }
        }
        const f32x2 b3 = *(const f32x2*)(fb3 + col0);
        const float d0 = dmin + (float)(c0) * ((dmax - dmin) / 511.0f), d1 = dmin + (float)(c0 + 1) * ((dmax - dmin) / 511.0f);
        float ss0 = 0.f, ss1 = 0.f;
#pragma unroll
        for (int tt = 0; tt < 32; ++tt) { const int i = t0 + tt + dir; const float tl_ = (float)i * (1.0f / 8191.0f);
            float v0 = (acc[tt][0] + b3[0]) * __expf(-tl_ * d0), v1 = (acc[tt][1] + b3[1]) * __expf(-tl_ * d1); if (i >= 8192) { v0 = 0.f; v1 = 0.f; }
            ss0 += v0 * v0; ss1 += v1 * v1;
            tl[(tid * 2) * 34 + tt] = (f16)v0; tl[(tid * 2 + 1) * 34 + tt] = (f16)v1; }
        *(f32x2*)(part + (size_t)tile * 2048 + col0) = (f32x2){ss0, ss1};
        __syncthreads();
#pragma unroll 1
        for (int it = 0; it < 8; ++it) { const int chunk = it * NTHR + opaque(tid), row = chunk >> 2, p = chunk & 3;
            f16x8 o;
            if (dir == 0) {
#pragma unroll
                for (int e = 0; e < 8; ++e) o[e] = tl[row * 34 + p * 8 + e];
                *(f16x8*)(kT + (size_t)row * NFFT + t0 + p * 8) = o;
            } else {
#pragma unroll
                for (int e = 0; e < 8; ++e) o[e] = tl[row * 34 + 31 - p * 8 - e];
                *(f16x8*)(kT + (size_t)row * NFFT + (NFFT - t0 - 32) + p * 8) = o;
            }
        }
        __syncthreads();
    }
}

__device__ __forceinline__ void p0_prologue(const Args& A, LAS unsigned char* lds, int tid, int lane, int wave) {
    unsigned char* ws = A.ws;
    LAS float* scr = (LAS float*)(lds + wave * 16384);
    const int gw = blockIdx.x * NWAVES + wave, NGW = gridDim.x * NWAVES;
    constexpr int I_UP = (D / 64) * (FF / 32), I_DN = (FF / 64) * (D / 32), I_IN = (D / 64) * (5120 / 32), I_P = (512 / 64) * (D / 32), I_O = (D / 64) * (D / 32);
    constexpr int NITEMS = 6 * I_UP   + I_IN + 2 * I_P + I_O;
    static_assert(I_UP == I_DN, "item counts");
    for (int it = gw; it < NITEMS; it += NGW) {
        int r = it;
        if (r < I_UP) { p0_transpose_item(A.in[3], D, FF, (bf16*)(ws + WS_W13A), 1, 0, scr, r, lane); continue; } r -= I_UP;
        if (r < I_UP) { p0_transpose_item(A.in[4], D, FF, (bf16*)(ws + WS_W13A), 1, 128, scr, r, lane); continue; } r -= I_UP;
        if (r < I_DN) { p0_transpose_item(A.in[5], FF, D, (bf16*)(ws + WS_W2A), 0, 0, scr, r, lane); continue; } r -= I_DN;
        if (r < I_IN) { p0_transpose_item(A.in[6], D, 5120, (bf16*)(ws + WS_WIN), 0, 0, scr, r, lane); continue; } r -= I_IN;
        if (r < I_P) { p0_transpose_item(A.in[19], 512, D, (bf16*)(ws + WS_WPA), 0, 0, scr, r, lane); continue; } r -= I_P;
        if (r < I_P) { p0_transpose_item(A.in[20], 512, D, (bf16*)(ws + WS_WPB), 0, 0, scr, r, lane); continue; } r -= I_P;
        if (r < I_O) { p0_transpose_item(A.in[21], D, D, (bf16*)(ws + WS_WOUT), 0, 0, scr, r, lane); continue; } r -= I_O;
        if (r < I_UP) { p0_transpose_item(A.in[24], D, FF, (bf16*)(ws + WS_W13B), 1, 0, scr, r, lane); continue; } r -= I_UP;
        if (r < I_UP) { p0_transpose_item(A.in[25], D, FF, (bf16*)(ws + WS_W13B), 1, 128, scr, r, lane); continue; } r -= I_UP;
        p0_transpose_item(A.in[26], FF, D, (bf16*)(ws + WS_W2B), 0, 0, scr, r, lane);
    }
    { const f32x4* x4 = (const f32x4*)A.in[0]; u32x4* o4 = (u32x4*)(ws + WS_XB);
      for (size_t i = (size_t)blockIdx.x * NTHR + tid; i < (size_t)M * D / 8; i += (size_t)gridDim.x * NTHR) { const f32x4 a = x4[2 * i], b = x4[2 * i + 1];
          u32x4 w; w.x = pkbf(a[0], a[1]); w.y = pkbf(a[2], a[3]); w.z = pkbf(b[0], b[1]); w.w = pkbf(b[2], b[3]); o4[i] = w; } }
    __syncthreads();
    for (int pr = blockIdx.x; pr < 128; pr += gridDim.x) { filter_tile(A, lds, 2 * pr, tid); filter_tile(A, lds, 2 * pr + 1, tid); }
}

__device__ __forceinline__ void ln_phase(const float* src, float* dst, bf16* xb, const float* g, const float* b, int lane, int wave) {
    const int gw = blockIdx.x * NWAVES + wave, NGW = gridDim.x * NWAVES;
    f32x4 gv[4], bv[4];
#pragma unroll
    for (int j = 0; j < 4; ++j) { gv[j] = ((const f32x4*)g)[lane + 64 * j]; bv[j] = ((const f32x4*)b)[lane + 64 * j]; }
    for (int m = gw; m < M; m += NGW) {
        const f32x4* xr = (const f32x4*)(src + (size_t)m * D) + lane;
        f32x4 v[4]; float s = 0.f;
#pragma unroll
        for (int j = 0; j < 4; ++j) { v[j] = xr[64 * j]; s += (v[j][0] + v[j][1]) + (v[j][2] + v[j][3]); }
        const float mean = wave_sum(s) * (1.f / D); float s2 = 0.f;
#pragma unroll
        for (int j = 0; j < 4; ++j) { v[j] = v[j] - mean; s2 += (v[j][0] * v[j][0] + v[j][1] * v[j][1]) + (v[j][2] * v[j][2] + v[j][3] * v[j][3]); }
        const float rstd = 1.0f / sqrtf(wave_sum(s2) * (1.f / D) + LN_EPS);
        f32x4* orow = (f32x4*)(dst + (size_t)m * D) + lane;
#pragma unroll
        for (int j = 0; j < 4; ++j) { const f32x4 o = v[j] * rstd * gv[j] + bv[j]; orow[64 * j] = o;
            if (xb) { u32x2 w; w.x = pkbf(o[0], o[1]); w.y = pkbf(o[2], o[3]); ((u32x2*)(xb + (size_t)m * D))[lane + 64 * j] = w; } }
    }
}
typedef f32x2 cplx;
__device__ __forceinline__ cplx cmul(cplx a, cplx b) { return (cplx){a[0] * b[0] - a[1] * b[1], a[0] * b[1] + a[1] * b[0]}; }
__device__ __forceinline__ cplx cmulc(cplx a, cplx b) { return (cplx){a[0] * b[0] + a[1] * b[1], a[1] * b[0] - a[0] * b[1]}; }
__device__ __forceinline__ int swz(int i) { return i ^ ((i >> 5) & 3) ^ (((i >> 6) & 7) << 2); }
__device__ __forceinline__ cplx twd(const LAS cplx* T1, const LAS cplx* T2, int e) { return cmul(T1[e >> 7], T2[e & 127]); }
__device__ __forceinline__ void bfly_f(cplx& a0, cplx& a1, cplx& a2, cplx& a3) {
    const cplx t0 = a0 + a2, t1 = a0 - a2, t2 = a1 + a3, d = a1 - a3; const cplx t3 = (cplx){d[1], -d[0]};
    a0 = t0 + t2; a1 = t1 + t3; a2 = t0 - t2; a3 = t1 - t3;
}
__device__ __forceinline__ void bfly_i(cplx& a0, cplx& a1, cplx& a2, cplx& a3) {
    const cplx t0 = a0 + a2, t1 = a0 - a2, t2 = a1 + a3, d = a1 - a3; const cplx t3 = (cplx){-d[1], d[0]};
    a0 = t0 + t2; a1 = t1 + t3; a2 = t0 - t2; a3 = t1 - t3;
}
template <int LQ> __device__ __forceinline__ void fwd16(cplx (&r)[16], int j0, const LAS cplx* T1, const LAS cplx* T2) {
    constexpr int SA = 10 - LQ;
#pragma unroll
    for (int c = 0; c < 4; ++c) {
        bfly_f(r[c], r[c + 4], r[c + 8], r[c + 12]);
        const cplx w1 = twd(T1, T2, (j0 + (c << LQ)) << SA), w2 = cmul(w1, w1), w3 = cmul(w1, w2);
        r[c + 4] = cmul(r[c + 4], w1); r[c + 8] = cmul(r[c + 8], w2); r[c + 12] = cmul(r[c + 12], w3);
    }
    const cplx v1 = twd(T1, T2, j0 << (SA + 2)), v2 = cmul(v1, v1), v3 = cmul(v1, v2);
#pragma unroll
    for (int m = 0; m < 4; ++m) {
        bfly_f(r[4 * m], r[4 * m + 1], r[4 * m + 2], r[4 * m + 3]);
        r[4 * m + 1] = cmul(r[4 * m + 1], v1); r[4 * m + 2] = cmul(r[4 * m + 2], v2); r[4 * m + 3] = cmul(r[4 * m + 3], v3);
    }
}
template <int LQ> __device__ __forceinline__ void inv16(cplx (&r)[16], int j0, const LAS cplx* T1, const LAS cplx* T2) {
    constexpr int SA = 10 - LQ;
    const cplx v1 = twd(T1, T2, j0 << (SA + 2)), v2 = cmul(v1, v1), v3 = cmul(v1, v2);
#pragma unroll
    for (int m = 0; m < 4; ++m) {
        r[4 * m + 1] = cmulc(r[4 * m + 1], v1); r[4 * m + 2] = cmulc(r[4 * m + 2], v2); r[4 * m + 3] = cmulc(r[4 * m + 3], v3);
        bfly_i(r[4 * m], r[4 * m + 1], r[4 * m + 2], r[4 * m + 3]);
    }
#pragma unroll
    for (int c = 0; c < 4; ++c) {
        const cplx w1 = twd(T1, T2, (j0 + (c << LQ)) << SA), w2 = cmul(w1, w1), w3 = cmul(w1, w2);
        r[c + 4] = cmulc(r[c + 4], w1); r[c + 8] = cmulc(r[c + 8], w2); r[c + 12] = cmulc(r[c + 12], w3);
        bfly_i(r[c], r[c + 4], r[c + 8], r[c + 12]);
    }
}
template <int LQ, bool INV> __device__ __forceinline__ void lds_pass16(LAS cplx* Z, const LAS cplx* T1, const LAS cplx* T2, int tid) {
#pragma unroll 1
    for (int h = 0; h < 2; ++h) { const int s = opaque(tid) + h * NTHR, j0 = s & ((1 << LQ) - 1), g = (s >> LQ) << (LQ + 4);
        cplx r[16];
#pragma unroll
        for (int k = 0; k < 16; ++k) r[k] = Z[swz(g + j0 + (k << LQ))];
        if (INV) inv16<LQ>(r, j0, T1, T2); else fwd16<LQ>(r, j0, T1, T2);
#pragma unroll
        for (int k = 0; k < 16; ++k) Z[swz(g + j0 + (k << LQ))] = r[k];
    }
}
__device__ __forceinline__ float block_sum(float v, LAS float* red, int tid) {
    v = wave_sum(v); __syncthreads(); if ((tid & 63) == 0) red[tid >> 6] = v; __syncthreads();
    float s = 0.f;
#pragma unroll
    for (int i = 0; i < NWAVES; ++i) s += red[i];
    return s;
}
__device__ __forceinline__ float short_conv(const f16* uT, const float* sw, const float* sb, int ch, int b, int t) {
    const f16* p = uT + (size_t)ch * M + b * SEQ + t;
    const float um = t > 0 ? (float)p[-1] : 0.f, u0 = (float)p[0], up = t < SEQ - 1 ? (float)p[1] : 0.f;
    return sb[ch] + sw[ch] * um + sw[1536 + ch] * u0 + sw[3072 + ch] * up;
}

__device__ __forceinline__ void hyena_channel(const Args& A, LAS unsigned char* lds, int c, int tid) {
    LAS cplx* Z = (LAS cplx*)lds; const LAS cplx* T1 = (const LAS cplx*)(lds + 131072); const LAS cplx* T2 = T1 + 128; LAS float* red = (LAS float*)(lds + 131072 + 2048);
    f16* uT = (f16*)(A.ws + WS_UT); const f16* kT = (const f16*)(A.ws + WS_KT); const float* part = (const float*)(A.ws + WS_PART);
    const float* sw = A.in[9]; const float* sb = A.in[10]; const float* hb = A.in[18];
    unsigned long long* KC = (unsigned long long*)(A.ws + WS_KC) + (size_t)blockIdx.x * NFFT;
    float zr[2][8][2];
    { const float v_b = sb[c], v_w0 = sw[c], v_w1 = sw[1536 + c], v_w2 = sw[3072 + c];
#pragma unroll
    for (int h = 0; h < 2; ++h)
#pragma unroll
        for (int k = 0; k < 8; ++k) {
#pragma unroll
            for (int b = 0; b < 2; ++b) { const int t = tid + h * NTHR + 1024 * k; const f16* p = uT + (size_t)c * M + b * SEQ + t;
                const float um = t > 0 ? (float)p[-1] : 0.f, u0 = (float)p[0], up = t < SEQ - 1 ? (float)p[1] : 0.f;
                zr[h][k][b] = v_b + v_w0 * um + v_w1 * u0 + v_w2 * up; }
            if ((k & 1) == 1) __builtin_amdgcn_sched_barrier(0); } }
#pragma unroll 1
    for (int n = 0; n < 2; ++n) {
        const float ssq = block_sum(part[(size_t)(tid >> 1) * 2048 + (tid & 1) * 1024 + n * 512 + c], red, tid);
        const float kscale = 1.0f / sqrtf(ssq + 1e-12f);
        const f16* kr = kT + (size_t)(n * 512 + c) * NFFT;
#ifndef SK1
#pragma unroll 1
        for (int h = 0; h < 2; ++h) { const int j0 = opaque(tid) + h * NTHR; cplx r[16];
#pragma unroll
            for (int k = 0; k < 16; ++k) r[k] = (cplx){(float)kr[j0 + 1024 * k] * kscale, 0.f};
            fwd16<10>(r, j0, T1, T2);
#pragma unroll
            for (int k = 0; k < 16; ++k) Z[swz(j0 + 1024 * k)] = r[k]; }
#endif
        __syncthreads();
#ifndef SK2
        lds_pass16<6, false>(Z, T1, T2, tid); __syncthreads();
        lds_pass16<2, false>(Z, T1, T2, tid); __syncthreads();
#endif
#pragma unroll 1
        for (int it = 0; it < 8; ++it) { const int bf = it * NTHR + opaque(tid);
            cplx a0 = Z[swz(4 * bf)], a1 = Z[swz(4 * bf + 1)], a2 = Z[swz(4 * bf + 2)], a3 = Z[swz(4 * bf + 3)];
            bfly_f(a0, a1, a2, a3);
            f32x4* o = (f32x4*)(KC + 4 * bf); o[0] = (f32x4){a0[0], a0[1], a1[0], a1[1]}; o[1] = (f32x4){a2[0], a2[1], a3[0], a3[1]}; }
        asm volatile("s_waitcnt vmcnt(0)" ::: "memory");
        __syncthreads();
#pragma unroll 1
        for (int h = 0; h < 2; ++h) { const int j0 = opaque(tid) + h * NTHR; cplx r[16];
#pragma unroll
            for (int k = 0; k < 8; ++k) { r[k] = h ? (cplx){zr[1][k][0], zr[1][k][1]} : (cplx){zr[0][k][0], zr[0][k][1]}; r[k + 8] = (cplx){0.f, 0.f}; }
            fwd16<10>(r, j0, T1, T2);
#pragma unroll
            for (int k = 0; k < 16; ++k) Z[swz(j0 + 1024 * k)] = r[k];
            __builtin_amdgcn_sched_barrier(0); }
        __syncthreads();
        lds_pass16<6, false>(Z, T1, T2, tid); __syncthreads();
        lds_pass16<2, false>(Z, T1, T2, tid); __syncthreads();
#pragma unroll 1
        for (int it = 0; it < 8; ++it) { const int bf = it * NTHR + opaque(tid);
            cplx a0 = Z[swz(4 * bf)], a1 = Z[swz(4 * bf + 1)], a2 = Z[swz(4 * bf + 2)], a3 = Z[swz(4 * bf + 3)];
            bfly_f(a0, a1, a2, a3);
            unsigned long long k0 = __hip_atomic_load(KC + 4 * bf, __ATOMIC_RELAXED, __HIP_MEMORY_SCOPE_AGENT), k1 = __hip_atomic_load(KC + 4 * bf + 1, __ATOMIC_RELAXED, __HIP_MEMORY_SCOPE_AGENT),
                               k2 = __hip_atomic_load(KC + 4 * bf + 2, __ATOMIC_RELAXED, __HIP_MEMORY_SCOPE_AGENT), k3 = __hip_atomic_load(KC + 4 * bf + 3, __ATOMIC_RELAXED, __HIP_MEMORY_SCOPE_AGENT);
            a0 = cmul(a0, (cplx){__uint_as_float((unsigned)k0), __uint_as_float((unsigned)(k0 >> 32))});
            a1 = cmul(a1, (cplx){__uint_as_float((unsigned)k1), __uint_as_float((unsigned)(k1 >> 32))});
            a2 = cmul(a2, (cplx){__uint_as_float((unsigned)k2), __uint_as_float((unsigned)(k2 >> 32))});
            a3 = cmul(a3, (cplx){__uint_as_float((unsigned)k3), __uint_as_float((unsigned)(k3 >> 32))});
            bfly_i(a0, a1, a2, a3);
            Z[swz(4 * bf)] = a0; Z[swz(4 * bf + 1)] = a1; Z[swz(4 * bf + 2)] = a2; Z[swz(4 * bf + 3)] = a3; }
        __syncthreads();
        lds_pass16<2, true>(Z, T1, T2, tid); __syncthreads();
        lds_pass16<6, true>(Z, T1, T2, tid); __syncthreads();
        const float bias = hb[n * 512 + c];
        const int gch = (n + 1) * 512 + c;
        const float g_b = sb[gch], g_w0 = sw[gch], g_w1 = sw[1536 + gch], g_w2 = sw[3072 + gch];
#pragma unroll 1
        for (int h = 0; h < 2; ++h) { const int j0 = opaque(tid) + h * NTHR; cplx r[16];
#pragma unroll
            for (int k = 0; k < 16; ++k) r[k] = Z[swz(j0 + 1024 * k)];
            inv16<10>(r, j0, T1, T2);
            __builtin_amdgcn_sched_barrier(0);
#pragma unroll
            for (int k = 0; k < 8; ++k) {
#pragma unroll
                for (int b = 0; b < 2; ++b) { const int t = j0 + 1024 * k; const f16* p = uT + (size_t)gch * M + b * SEQ + t;
                    const float um = t > 0 ? (float)p[-1] : 0.f, u0 = (float)p[0], up = t < SEQ - 1 ? (float)p[1] : 0.f;
                    const float gate = g_b + g_w0 * um + g_w1 * u0 + g_w2 * up;
                    const float zo = h ? zr[1][k][b] : zr[0][k][b]; const float zn = gate * (r[k][b] * (1.0f / NFFT) + bias * zo);
                    if (h) zr[1][k][b] = zn; else zr[0][k][b] = zn; }
                if ((k & 1) == 1) __builtin_amdgcn_sched_barrier(0); }
        }
        __syncthreads();
    }
#pragma unroll
    for (int h = 0; h < 2; ++h)
#pragma unroll
        for (int k = 0; k < 8; ++k)
#pragma unroll
            for (int b = 0; b < 2; ++b) uT[(size_t)c * M + b * SEQ + tid + h * NTHR + 1024 * k] = (f16)zr[h][k][b];
}

__device__ __forceinline__ void na_unit(const Args& A, int u, int lane) {
    bf16* Q = (bf16*)(A.ws + WS_Q); const bf16* Kb = (const bf16*)(A.ws + WS_K); const bf16* Vt = (const bf16*)(A.ws + WS_VT); const float* rpb = A.in[8];
    const int jq = u & 3, r = (u >> 2) & 127, hh = (u >> 9) & 7, b = u >> 12, fr = lane & 15, fq = lane >> 4;
    const int rs = min(max(r - 4, 0), 120), wb = min(max(16 * jq - 8, 0), 32), c = 16 * jq + fr, cs = min(max(c - 8, 0), 48);
    const size_t qrow = (size_t)b * SEQ + r * 64 + c;
    const bf16x8 q0 = *(const bf16x8*)(Q + qrow * 512 + hh * 64 + 8 * fq), q1 = *(const bf16x8*)(Q + qrow * 512 + hh * 64 + 32 + 8 * fq);
    float s[8][2][4]; float mx = -1e30f;
#pragma unroll
    for (int a = 0; a < 8; ++a) { const int dr = rs + a - r + 7;
#pragma unroll
        for (int ct = 0; ct < 2; ++ct) { const size_t tok = (size_t)b * SEQ + (rs + a) * 64 + wb + 16 * ct + fr;
            const bf16x8 k0 = *(const bf16x8*)(Kb + tok * 512 + hh * 64 + 8 * fq), k1 = *(const bf16x8*)(Kb + tok * 512 + hh * 64 + 32 + 8 * fq);
            f32x4 acc = {0.f, 0.f, 0.f, 0.f};
            acc = __builtin_amdgcn_mfma_f32_16x16x32_bf16(k0, q0, acc, 0, 0, 0); acc = __builtin_amdgcn_mfma_f32_16x16x32_bf16(k1, q1, acc, 0, 0, 0);
#pragma unroll
            for (int i = 0; i < 4; ++i) { const int kc = wb + 16 * ct + 4 * fq + i; const bool ok = (kc >= cs) && (kc < cs + 16); const int dc = min(max(kc - c + 15, 0), 30);
                const float v = ok ? acc[i] + rpb[(hh * 15 + dr) * 31 + dc] : -1e30f; s[a][ct][i] = v; mx = fmaxf(mx, v); } } }
    mx = fmaxf(mx, __shfl_xor(mx, 16)); mx = fmaxf(mx, __shfl_xor(mx, 32));
    float sum = 0.f;
#pragma unroll
    for (int a = 0; a < 8; ++a)
#pragma unroll
        for (int ct = 0; ct < 2; ++ct)
#pragma unroll
            for (int i = 0; i < 4; ++i) { const float p = __expf(s[a][ct][i] - mx); s[a][ct][i] = p; sum += p; }
    sum += __shfl_xor(sum, 16); sum += __shfl_xor(sum, 32);
    const float inv = 1.0f / sum;
    f32x4 o[4];
#pragma unroll
    for (int dt = 0; dt < 4; ++dt) o[dt] = (f32x4){0.f, 0.f, 0.f, 0.f};
#pragma unroll
    for (int a = 0; a < 8; ++a) {
        u32x4 pw; pw.x = pkbf(s[a][0][0], s[a][0][1]); pw.y = pkbf(s[a][0][2], s[a][0][3]); pw.z = pkbf(s[a][1][0], s[a][1][1]); pw.w = pkbf(s[a][1][2], s[a][1][3]);
        const bf16x8 pb = __builtin_bit_cast(bf16x8, pw);
#pragma unroll
        for (int dt = 0; dt < 4; ++dt) { const bf16* vp = Vt + (((size_t)(b * 512 + hh * 64 + 16 * dt + fr)) << 13) + (rs + a) * 64 + wb + 4 * fq;
            const u32x2 lo = *(const u32x2*)vp, hi = *(const u32x2*)(vp + 16);
            const bf16x8 vf = __builtin_bit_cast(bf16x8, (u32x4){lo.x, lo.y, hi.x, hi.y});
            o[dt] = __builtin_amdgcn_mfma_f32_16x16x32_bf16(vf, pb, o[dt], 0, 0, 0); } }
#pragma unroll
    for (int dt = 0; dt < 4; ++dt) { u32x2 w; w.x = pkbf(o[dt][0] * inv, o[dt][1] * inv); w.y = pkbf(o[dt][2] * inv, o[dt][3] * inv);
        *(u32x2*)(Q + qrow * 512 + hh * 64 + 16 * dt + 4 * fq) = w; }
}

__device__ __forceinline__ void transpose_yb(const Args& A, LAS unsigned char* lds, int tid) {
    const f16* ybT = (const f16*)(A.ws + WS_UT); bf16* yb = (bf16*)(A.ws + WS_YB); LAS float* tl = (LAS float*)lds;
    for (int tile = blockIdx.x; tile < 8 * 256; tile += gridDim.x) { const int c0 = (tile & 7) * 64, k0 = (tile >> 3) * 64;
        { const int ci = tid >> 3, tj = (tid & 7) * 8; const f16x8 v = *(const f16x8*)(ybT + (size_t)(c0 + ci) * M + k0 + tj);
#pragma unroll
          for (int e = 0; e < 8; ++e) tl[ci * 65 + tj + e] = (float)v[e]; }
        __syncthreads();
        { const int ti = tid >> 3, cj = (tid & 7) * 8; float o[8];
#pragma unroll
          for (int e = 0; e < 8; ++e) o[e] = tl[(cj + e) * 65 + ti];
          u32x4 w; w.x = pkbf(o[0], o[1]); w.y = pkbf(o[2], o[3]); w.z = pkbf(o[4], o[5]); w.w = pkbf(o[6], o[7]);
          *(u32x4*)(yb + (size_t)(k0 + ti) * 512 + c0 + cj) = w; }
        __syncthreads();
    }
}
#define XB_TMO      128
#define XB_XCNT(j)  (256  + 64 * (j))
#define XB_XSUB(j)  (1280 + 64 * (j))
#define XB_XGEN(j)  (2304 + 64 * (j))
#define XB_TOP      3328
#define XB_TOPGEN   3392
#define XCD_BAR_WORDS 3456
#define XB_SPIN_CAP (1u << 18)

__device__ __forceinline__ unsigned xb_ld(unsigned* p)              { return __hip_atomic_load(p, __ATOMIC_RELAXED, __HIP_MEMORY_SCOPE_AGENT); }
__device__ __forceinline__ unsigned xb_add(unsigned* p, unsigned v) { return __hip_atomic_fetch_add(p, v, __ATOMIC_RELAXED, __HIP_MEMORY_SCOPE_AGENT); }
__device__ __forceinline__ unsigned xb_xcc_id() { return (unsigned)__builtin_amdgcn_s_getreg((3 << 11) | 20) & 0xFu; }
#define XB_SPIN(cond, bar) do { unsigned _sp = 0; while (cond) { __builtin_amdgcn_s_sleep(1); \
    if ((++_sp & 255u) == 0u) { if (xb_ld(&(bar)[XB_TMO])) break; if (_sp > XB_SPIN_CAP) { atomicAdd(&(bar)[XB_TMO], 1u); break; } } } } while (0)

struct XcdBarrier {
    unsigned* bar; unsigned x;
    volatile LAS unsigned* st;
};

__device__ __forceinline__ XcdBarrier xcd_barrier_post(unsigned* bar, volatile LAS unsigned* st) {
    XcdBarrier b; b.bar = bar; b.x = xb_xcc_id(); b.st = st;
    if (threadIdx.x == 0) (void)xb_add(&bar[XB_XCNT(b.x)], 1u);
    return b;
}
__device__ __forceinline__ void xcd_barrier_complete(unsigned* bar, unsigned x, unsigned& nloc, unsigned& nx) {
    const unsigned G = gridDim.x * gridDim.y * gridDim.z;
    unsigned sum, cnt, mine, sp = 0u;
    for (;;) {
        sum = 0u; cnt = 0u; mine = 0u;
#pragma unroll
        for (unsigned j = 0; j < 16; ++j) { const unsigned c = xb_ld(&bar[XB_XCNT(j)]); sum += c; cnt += (c > 0u) ? 1u : 0u; mine = (j == x) ? c : mine; }
        if (sum == G) break;
        __builtin_amdgcn_s_sleep(1);
        if ((++sp & 255u) == 0u) { if (xb_ld(&bar[XB_TMO])) break; if (sp > XB_SPIN_CAP) { atomicAdd(&bar[XB_TMO], 1u); break; } }
    }
    nloc = mine > 0u ? mine : 1u; nx = cnt > 0u ? cnt : 1u;
}

__device__ __forceinline__ void xcd_barrier(const XcdBarrier& b) {
    asm volatile("s_waitcnt vmcnt(0)" ::: "memory");
    __syncthreads();
    if (threadIdx.x == 0) {
        unsigned* bar = b.bar;
        __builtin_amdgcn_s_waitcnt(0);
        unsigned nloc = b.st[0], nx = b.st[1];
        if (nloc == 0u) { xcd_barrier_complete(bar, b.x, nloc, nx); b.st[0] = nloc; b.st[1] = nx; }
        const unsigned old = xb_add(&bar[XB_XSUB(b.x)], 1u);
        const unsigned gen = old / nloc;
        if (old + 1u == (gen + 1u) * nloc) {
            __builtin_amdgcn_fence(__ATOMIC_RELEASE, "agent");
            asm volatile("s_waitcnt vmcnt(0)" ::: "memory");
            const unsigned og = xb_add(&bar[XB_TOP], 1u);
            const unsigned tg = og / nx;
            if (og + 1u == (tg + 1u) * nx) xb_add(&bar[XB_TOPGEN], 1u);
            else XB_SPIN(xb_ld(&bar[XB_TOPGEN]) == tg, bar);
            __builtin_amdgcn_fence(__ATOMIC_ACQUIRE, "agent");
            xb_add(&bar[XB_XGEN(b.x)], 1u);
            asm volatile("s_waitcnt vmcnt(0)" ::: "memory");
        } else {
            XB_SPIN(xb_ld(&bar[XB_XGEN(b.x)]) == gen, bar);
            __builtin_amdgcn_fence(__ATOMIC_ACQUIRE, "agent");
            asm volatile("s_waitcnt vmcnt(0)" ::: "memory");
        }
    }
    __syncthreads();
}

__global__ void __launch_bounds__(NTHR, 2) mk_fwd(Args A) {
    extern __shared__ __attribute__((aligned(16))) unsigned char lds_raw[];
    LAS unsigned char* lds = (LAS unsigned char*)lds_raw;
    const int tid = threadIdx.x, lane = tid & 63, wave = __builtin_amdgcn_readfirstlane(tid >> 6);
    cg::grid_group grid = cg::this_grid();
    if (tid < 2) ((volatile LAS unsigned*)(lds + 140000))[tid] = 0u;
    __syncthreads();
    XcdBarrier xbar = xcd_barrier_post((unsigned*)A.ws + 4096, (volatile LAS unsigned*)(lds + 140000));
    const int lo = A.ph_lo, hi = A.ph_hi, G = gridDim.x, bx = blockIdx.x;
    unsigned char* ws = A.ws;
#ifndef PMASK
#define PMASK 0x3fff
#endif
#define IN(k) (((PMASK >> (k)) & 1) && ((lo <= (k) && (k) < hi) || ((k) == 13 && lo <= 6 && hi >= 8) || (lo == 13 && (k) == 13)))
#define GSYNC() do { xcd_barrier(xbar); } while (0)
#define SEAM(k) do { if (IN(k) && IN((k) + 1)) GSYNC(); } while (0)
    bf16* XB = (bf16*)(ws + WS_XB); bf16* HB = (bf16*)(ws + WS_H); float* R = A.out;

    if (IN(0)) { p0_prologue(A, lds, tid, lane, wave); }
    if (IN(0) && IN(1)) { grid.sync(); }
    if (IN(1)) { pg8::Gemm g{XB, (const bf16*)(ws + WS_W13A), M, 2 * FF, D}; pg8::StaticOrder S; S.init(M, 2 * FF, G, bx); EpiSwiglu E{HB};
                 pg8::gemm_phase<EpiSwiglu, pg8::StaticOrder, true, true>(lds, g, S, E); } SEAM(1);
    if (IN(2)) { pg8::Gemm g{HB, (const bf16*)(ws + WS_W2A), M, D, FF}; pg8::StaticOrder S; S.init(M, D, G, bx); EpiResid E{A.in[0], R, 0.5f};
                 pg8::gemm_phase<EpiResid, pg8::StaticOrder, true, true>(lds, g, S, E); } SEAM(2);
    if (IN(3)) { ln_phase(R, R, XB, A.in[1], A.in[2], lane, wave); } SEAM(3);
    if (IN(4)) { pg8::Gemm g{XB, (const bf16*)(ws + WS_WIN), M, 3072, D}; pg8::StaticOrder S; S.init(M, 3072, G, bx);
                 EpiIn E{(bf16*)(ws + WS_Q), (bf16*)(ws + WS_K), (bf16*)(ws + WS_VT), (f16*)(ws + WS_UT)};
                 pg8::gemm_phase<EpiIn, pg8::StaticOrder, true, true>(lds, g, S, E); } SEAM(4);
    if (IN(5)) {
        if (tid < 256) { float s, c; const int k = tid & 127; sincospif(tid < 128 ? -(float)k * (1.0f / 64.0f) : -(float)k * (1.0f / 8192.0f), &s, &c);
            ((LAS cplx*)(lds + 131072))[tid] = (cplx){c, s}; }
        __syncthreads();
        #ifndef NO_HY
        for (int c = bx; c < 512; c += G) hyena_channel(A, lds, c, tid);
#endif
        #ifndef NO_NA
        for (int u = bx * NWAVES + wave; u < 8192; u += G * NWAVES) na_unit(A, u, lane);
#endif
    } SEAM(5);
    if (IN(6)) { transpose_yb(A, lds, tid); } SEAM(6);
    if (IN(13)) { pg8::Gemm g{XB, (const bf16*)(ws + WS_WIN) + (size_t)3072 * D, M, 2048, D}; pg8::StaticOrder S; S.init(M, 2048, G, bx); EpiGate E{(bf16*)(ws + WS_GATE), A.in[7]};
                  pg8::gemm_phase<EpiGate, pg8::StaticOrder, true, true>(lds, g, S, E); }
    if (IN(13) && IN(7)) GSYNC();
    if (IN(7)) { pg8::StaticOrder S; S.init(M, D, G, bx);
                 { pg8::Gemm g{(const bf16*)(ws + WS_Q), (const bf16*)(ws + WS_WPA), M, D, 512}; EpiMix<0> E{(bf16*)(ws + WS_MIX), (const bf16*)(ws + WS_GATE)};
                   pg8::gemm_phase<EpiMix<0>, pg8::StaticOrder, true, true>(lds, g, S, E); }
                 { pg8::Gemm g{(const bf16*)(ws + WS_YB), (const bf16*)(ws + WS_WPB), M, D, 512}; EpiMix<1> E{(bf16*)(ws + WS_MIX), (const bf16*)(ws + WS_GATE)};
                   pg8::gemm_phase<EpiMix<1>, pg8::StaticOrder, true, true>(lds, g, S, E); } } SEAM(7);
    if (IN(8)) { pg8::Gemm g{(const bf16*)(ws + WS_MIX), (const bf16*)(ws + WS_WOUT), M, D, D}; pg8::StaticOrder S; S.init(M, D, G, bx); EpiResid E{R, R, 1.0f};
                 pg8::gemm_phase<EpiResid, pg8::StaticOrder, true, true>(lds, g, S, E); } SEAM(8);
    if (IN(9)) { ln_phase(R, R, XB, A.in[22], A.in[23], lane, wave); } SEAM(9);
    if (IN(10)) { pg8::Gemm g{XB, (const bf16*)(ws + WS_W13B), M, 2 * FF, D}; pg8::StaticOrder S; S.init(M, 2 * FF, G, bx); EpiSwiglu E{HB};
                  pg8::gemm_phase<EpiSwiglu, pg8::StaticOrder, true, true>(lds, g, S, E); } SEAM(10);
    if (IN(11)) { pg8::Gemm g{HB, (const bf16*)(ws + WS_W2B), M, D, FF}; pg8::StaticOrder S; S.init(M, D, G, bx); EpiResid E{R, R, 0.5f};
                  pg8::gemm_phase<EpiResid, pg8::StaticOrder, true, true>(lds, g, S, E); } SEAM(11);
    if (IN(12)) { ln_phase(R, R, nullptr, A.in[27], A.in[28], lane, wave); }
#undef IN
#undef SEAM
}

extern "C" void kernel_launch(void* const* d_in, const int* in_sizes, int n_in, void* d_out, int out_size, void* d_ws, size_t ws_size, hipStream_t stream) {
    static int grid = 0;
    if (grid == 0) {
        if (n_in != 29 || in_sizes[0] != M * D || out_size != M * D || ws_size < WS_END) { fprintf(stderr, "kernel_launch: unexpected problem shape (n_in %d, ws %zu)\n", n_in, ws_size); grid = -1; return; }
        int dev = 0, cus = 0, per_cu = 0;
        (void)hipGetDevice(&dev); (void)hipDeviceGetAttribute(&cus, hipDeviceAttributeMultiprocessorCount, dev);
        if (hipFuncSetAttribute((const void*)mk_fwd, hipFuncAttributeMaxDynamicSharedMemorySize, LDS_BYTES) != hipSuccess) fprintf(stderr, "kernel_launch: hipFuncSetAttribute failed\n");
        if (hipOccupancyMaxActiveBlocksPerMultiprocessor(&per_cu, (const void*)mk_fwd, NTHR, LDS_BYTES) != hipSuccess || per_cu < 1) { fprintf(stderr, "kernel_launch: occupancy query says %d blocks per CU\n", per_cu); per_cu = 1; }
        (void)hipGetLastError();
        grid = cus * per_cu; if (grid > 256) grid = 256; if (grid < 1) grid = 1;
    }
    if (grid < 0) return;
    (void)hipMemsetAsync(d_ws, 0, 65536, stream);
    Args a{};
    for (int i = 0; i < 29; ++i) a.in[i] = (const float*)d_in[i];
    a.out = (float*)d_out; a.ws = (unsigned char*)d_ws;
#if MK_PER_PHASE
    const int order[14] = {0, 1, 2, 3, 4, 5, 6, 13, 7, 8, 9, 10, 11, 12};
    for (int i = 0; i < 14; ++i) { a.ph_lo = order[i]; a.ph_hi = order[i] + 1; hipLaunchKernelGGL(mk_fwd, dim3(grid), dim3(NTHR), LDS_BYTES, stream, a); }
#else
    a.ph_lo = 0; a.ph_hi = NPHASE;
    void* args[] = {&a};
    const hipError_t e = hipLaunchCooperativeKernel((const void*)mk_fwd, dim3(grid), dim3(NTHR), args, LDS_BYTES, stream);
    if (e != hipSuccess) fprintf(stderr, "kernel_launch: cooperative launch failed: %s (grid %d)\n", hipGetErrorString(e), grid);
#endif
}
```

```cpp
#include <hip/hip_runtime.h>
#include <hip/hip_cooperative_groups.h>
#include <cstdio>
#include <cstdint>
namespace cg = cooperative_groups;
namespace pg8 {
#define PG8_LAS __attribute__((address_space(3)))
typedef unsigned short bf16_t;
typedef short bf16x8 __attribute__((ext_vector_type(8)));
typedef float f32x4 __attribute__((ext_vector_type(4)));
typedef unsigned u32x4 __attribute__((ext_vector_type(4)));
constexpr int BM = 256, BK = 64, HALF = 128, HTB = HALF * BK * 2  , STAGE_BYTES = 8 * HTB, NXCD = 8, WGM = 8;

__host__ __device__ __forceinline__ int lds_byte(int r, int c) { const int st = (r >> 4) * 2 + (c >> 5), rr = r & 15, cc = c & 31, ob = rr * 64 + cc * 2; return st * 1024 + (ob ^ (((ob >> 9) & 1) << 5)); }
__host__ __device__ __forceinline__ void stage_rc(int b, int& R, int& C) { const int st = b / 1024, sb = b % 1024, swz = sb ^ (((sb >> 9) & 1) << 5); R = (st >> 1) * 16 + swz / 64; C = (st & 1) * 32 + (swz % 64) / 2; }
__host__ __device__ __forceinline__ int perm32(int rho) { const int n = rho >> 4, i = rho & 15; return 8 * (i >> 2) + 4 * n + (i & 3); }

struct Unit { int pm, pn; };
struct Gemm { const bf16_t* A; const bf16_t* Bt; int M, N, K; };

struct StaticOrder {
    int nM, nN, nwg, G, c;
    __host__ __device__ void init(int M, int N, int G_, int c_) { nM = M / BM; nN = N / BM; nwg = nM * nN; G = G_; c = c_; }
    __host__ __device__ bool next(int i, Unit& u) const {
        const long L = (long)i * G + c; if (L >= nwg) return false;
        int wgid = (int)L; { const int q = nwg / NXCD, r = nwg % NXCD, xcd = wgid % NXCD, off = wgid / NXCD; wgid = (xcd < r ? xcd * (q + 1) : r * (q + 1) + (xcd - r) * q) + off; }
        const int nig = WGM * nN, gid = wgid / nig, fm = gid * WGM, gsz = (nM - fm) < WGM ? (nM - fm) : WGM;
        u.pm = fm + ((wgid % nig) % gsz); u.pn = (wgid % nig) / gsz; return true;
    }
    __device__ __forceinline__ void a_ready(const Unit&) const {}
    __device__ __forceinline__ void done(const Unit&) const {}
};

__device__ __forceinline__ unsigned cvt_pk_bf16(float lo, float hi) { unsigned r; asm volatile("v_cvt_pk_bf16_f32 %0, %1, %2" : "=v"(r) : "v"(lo), "v"(hi)); return r; }
template <class Epi, class Sched, bool ALIGN_EPI = false, bool SP2 = false>
__device__ __forceinline__ void gemm_phase(PG8_LAS unsigned char* lds, const Gemm g, const Sched& S, const Epi& E) {
    const int tid = threadIdx.x, wid = __builtin_amdgcn_readfirstlane(tid >> 6), lane = tid & 63, wr = wid >> 2, wc = wid & 3, fr = lane & 15, fq = lane >> 4;
    const int K = g.K, nt = K / BK;
    unsigned voffA[2], voffB[2];
#pragma unroll
    for (int i = 0; i < 2; ++i) { int R, C; stage_rc(tid * 16 + i * 8192, R, C); const int Rb = Epi::PERM ? ((R & ~31) + perm32(R & 31)) : R;
        voffA[i] = (unsigned)(R * K + C) * 2u; voffB[i] = (unsigned)(Rb * K + C) * 2u; }
    const size_t kstep = (size_t)(BK * 2);
    const size_t hstep = (size_t)HALF * K * 2;
    const size_t tstep = 2 * hstep;
    const unsigned ldsw = (unsigned)wid * 1024u;
    const int aoff = lds_byte(wr * 64 + fr, fq * 8), boff = lds_byte(wc * 32 + fr, fq * 8);
#define PG8_SA(b, h) (((b) * 2 + (h)) * HTB)
#define PG8_SB(b, h) ((4 + (b) * 2 + (h)) * HTB)
#define PG8_STAGE(bufoff, gbase, voff) do { _Pragma("unroll") for (int _i = 0; _i < 2; ++_i) \
        __builtin_amdgcn_global_load_lds((const unsigned*)((const char*)(gbase) + (voff)[_i]), (PG8_LAS unsigned*)(lds + (bufoff) + ldsw + _i * 8192), 16, 0, 0); } while (0)
#define PG8_LDA(dst, b, h) do { _Pragma("unroll") for (int m = 0; m < 4; ++m) _Pragma("unroll") for (int k = 0; k < 2; ++k) dst[m][k] = *(const PG8_LAS bf16x8*)(lds + PG8_SA(b, h) + aoff + m * 2048 + k * 1024); } while (0)
#define PG8_LDB(dst, b, h) do { _Pragma("unroll") for (int n = 0; n < 2; ++n) _Pragma("unroll") for (int k = 0; k < 2; ++k) dst[n][k] = *(const PG8_LAS bf16x8*)(lds + PG8_SB(b, h) + boff + n * 2048 + k * 1024); } while (0)
#define PG8_MMA(ai, bj, At, Bt) do { __builtin_amdgcn_s_setprio(1); _Pragma("unroll") for (int m = 0; m < 4; ++m) _Pragma("unroll") for (int n = 0; n < 2; ++n) _Pragma("unroll") for (int k = 0; k < 2; ++k) \
        acc[ai][bj][m][n] = __builtin_amdgcn_mfma_f32_16x16x32_bf16(Bt[n][k], At[m][k], acc[ai][bj][m][n], 0, 0, 0); __builtin_amdgcn_s_setprio(0); } while (0)
#define PG8_WAIT_V(n) asm volatile("s_waitcnt vmcnt(" #n ")" ::: "memory")
#define PG8_WAIT_L(n) asm volatile("s_waitcnt lgkmcnt(" #n ")" ::: "memory")
#define PG8_BAR __builtin_amdgcn_s_barrier()
#define PG8_SCHED __builtin_amdgcn_sched_barrier(0)
    Unit cur, nxt; int ui = 0;
    if (!S.next(0, cur)) return;
    f32x4 acc[2][2][4][2];
#pragma unroll
    for (int a = 0; a < 2; ++a)
#pragma unroll
        for (int b = 0; b < 2; ++b)
#pragma unroll
            for (int m = 0; m < 4; ++m)
#pragma unroll
                for (int n = 0; n < 2; ++n) acc[a][b][m][n] = (f32x4){0.f, 0.f, 0.f, 0.f};
    bf16x8 At[4][2], B0[2][2], B1[2][2];
    const char* cA = (const char*)g.A + (size_t)cur.pm * tstep; const char* cB = (const char*)g.Bt + (size_t)cur.pn * tstep;
    S.a_ready(cur);
    if constexpr (SP2) {
        PG8_STAGE(PG8_SB(0, 0), cB, voffB); PG8_STAGE(PG8_SB(0, 1), cB + hstep, voffB); PG8_STAGE(PG8_SA(0, 0), cA, voffA); PG8_STAGE(PG8_SA(0, 1), cA + hstep, voffA);
        if (wr == 1) PG8_BAR;
        PG8_WAIT_V(2); PG8_BAR;
        PG8_STAGE(PG8_SB(1, 0), cB + kstep, voffB); PG8_STAGE(PG8_SA(1, 0), cA + kstep, voffA); PG8_STAGE(PG8_SB(1, 1), cB + hstep + kstep, voffB);
        PG8_WAIT_V(6); PG8_BAR;
    } else {
        PG8_STAGE(PG8_SB(0, 0), cB, voffB); PG8_STAGE(PG8_SA(0, 0), cA, voffA); PG8_STAGE(PG8_SB(0, 1), cB + hstep, voffB); PG8_STAGE(PG8_SA(0, 1), cA + hstep, voffA);
        if (wr == 1) PG8_BAR;
        PG8_WAIT_V(4); PG8_BAR;
        PG8_STAGE(PG8_SB(1, 0), cB + kstep, voffB); PG8_STAGE(PG8_SA(1, 0), cA + kstep, voffA); PG8_STAGE(PG8_SB(1, 1), cB + hstep + kstep, voffB);
        PG8_WAIT_V(6); PG8_BAR;
    }
    for (;;) {
        const bool has_next = S.next(ui + 1, nxt);
        const char* nA = has_next ? (const char*)g.A + (size_t)nxt.pm * tstep : cA; const char* nB = has_next ? (const char*)g.Bt + (size_t)nxt.pn * tstep : cB;
        for (int t = 0; t < nt; t += 2) {
            const bool last = (t == nt - 2);
            const char* a1 = cA + (size_t)(t + 1) * kstep;
            const char* a2 = last ? nA : cA + (size_t)(t + 2) * kstep; const char* b2 = last ? nB : cB + (size_t)(t + 2) * kstep;
            const char* a3 = a2 + kstep; const char* b3 = b2 + kstep;
            if (last && has_next) S.a_ready(nxt);
            if constexpr (SP2) {
            PG8_LDB(B0, 0, 0); PG8_LDB(B1, 0, 1); PG8_SCHED; PG8_LDA(At, 0, 0); PG8_STAGE(PG8_SA(1, 1), a1 + hstep, voffA);
            PG8_WAIT_V(8); PG8_WAIT_L(0); PG8_BAR; PG8_MMA(0, 0, At, B0); PG8_MMA(0, 1, At, B1); PG8_BAR; PG8_SCHED;
            PG8_LDA(At, 0, 1); PG8_STAGE(PG8_SB(0, 0), b2, voffB); PG8_STAGE(PG8_SB(0, 1), b2 + hstep, voffB); PG8_STAGE(PG8_SA(0, 0), a2, voffA);
            PG8_WAIT_V(8); PG8_WAIT_L(0); PG8_BAR; PG8_MMA(1, 0, At, B0); PG8_MMA(1, 1, At, B1); PG8_BAR; PG8_SCHED;
            PG8_LDB(B0, 1, 0); PG8_LDB(B1, 1, 1); PG8_SCHED; PG8_LDA(At, 1, 0); PG8_STAGE(PG8_SA(0, 1), a2 + hstep, voffA);
            PG8_WAIT_V(8); PG8_WAIT_L(0); PG8_BAR; PG8_MMA(0, 0, At, B0); PG8_MMA(0, 1, At, B1); PG8_BAR; PG8_SCHED;
            PG8_LDA(At, 1, 1); PG8_STAGE(PG8_SB(1, 0), b3, voffB); PG8_STAGE(PG8_SB(1, 1), b3 + hstep, voffB); PG8_STAGE(PG8_SA(1, 0), a3, voffA);
            PG8_WAIT_V(8); PG8_WAIT_L(0); PG8_BAR; PG8_MMA(1, 0, At, B0); PG8_MMA(1, 1, At, B1); PG8_BAR; PG8_SCHED;
            } else {
            PG8_LDB(B0, 0, 0); PG8_SCHED; PG8_LDA(At, 0, 0); PG8_STAGE(PG8_SA(1, 1), a1 + hstep, voffA);
            PG8_WAIT_L(8); PG8_BAR; PG8_WAIT_L(0); PG8_MMA(0, 0, At, B0); PG8_BAR; PG8_SCHED;
            PG8_LDB(B1, 0, 1); PG8_STAGE(PG8_SB(0, 0), b2, voffB);
            PG8_BAR; PG8_WAIT_L(0); PG8_MMA(0, 1, At, B1); PG8_BAR;
            PG8_LDA(At, 0, 1); PG8_STAGE(PG8_SA(0, 0), a2, voffA);
            PG8_BAR; PG8_WAIT_L(0); PG8_MMA(1, 0, At, B0); PG8_BAR; PG8_SCHED;
            PG8_STAGE(PG8_SB(0, 1), b2 + hstep, voffB);
            PG8_WAIT_V(6); PG8_BAR; PG8_MMA(1, 1, At, B1); PG8_BAR;
            PG8_LDB(B0, 1, 0); PG8_SCHED; PG8_LDA(At, 1, 0); PG8_STAGE(PG8_SA(0, 1), a2 + hstep, voffA);
            PG8_WAIT_L(8); PG8_BAR; PG8_WAIT_L(0); PG8_MMA(0, 0, At, B0); PG8_BAR; PG8_SCHED;
            PG8_LDB(B1, 1, 1); PG8_STAGE(PG8_SB(1, 0), b3, voffB);
            PG8_BAR; PG8_WAIT_L(0); PG8_MMA(0, 1, At, B1); PG8_BAR;
            PG8_LDA(At, 1, 1); PG8_STAGE(PG8_SA(1, 0), a3, voffA);
            PG8_BAR; PG8_WAIT_L(0); PG8_MMA(1, 0, At, B0); PG8_BAR; PG8_SCHED;
            PG8_STAGE(PG8_SB(1, 1), b3 + hstep, voffB);
            PG8_WAIT_V(6); PG8_BAR; PG8_MMA(1, 1, At, B1); PG8_BAR;
            }
        }
        if constexpr (ALIGN_EPI) { if (wr == 0) PG8_BAR; }
        if constexpr (!Epi::AFTER_DRAIN) { E(acc, cur, wr, wc, fr, fq); S.done(cur); }
        if (!has_next) break;
#pragma unroll
        for (int a = 0; a < 2; ++a)
#pragma unroll
            for (int b = 0; b < 2; ++b)
#pragma unroll
                for (int m = 0; m < 4; ++m)
#pragma unroll
                    for (int n = 0; n < 2; ++n) acc[a][b][m][n] = (f32x4){0.f, 0.f, 0.f, 0.f};
        cur = nxt; cA = nA; cB = nB; ++ui;
        if constexpr (ALIGN_EPI) { if (wr == 1) PG8_BAR; }
    }
    PG8_WAIT_V(0);
    if constexpr (!ALIGN_EPI) { if (wr == 0) PG8_BAR; }
    PG8_BAR;
    if constexpr (Epi::AFTER_DRAIN) { E.fused(acc, cur, wr, wc, fr, fq, lds, wid, lane); S.done(cur); }
#undef PG8_SA
#undef PG8_SB
#undef PG8_STAGE
#undef PG8_LDA
#undef PG8_LDB
#undef PG8_MMA
#undef PG8_WAIT_V
#undef PG8_WAIT_L
#undef PG8_BAR
#undef PG8_SCHED
}
}
#ifndef MK_PER_PHASE
#define MK_PER_PHASE 0
#endif
#define LAS __attribute__((address_space(3)))
typedef unsigned short bf16;
typedef _Float16 f16;
typedef float f32x4 __attribute__((ext_vector_type(4)));
typedef float f32x2 __attribute__((ext_vector_type(2)));
typedef short bf16x8 __attribute__((ext_vector_type(8)));
typedef unsigned u32x4 __attribute__((ext_vector_type(4)));
typedef unsigned u32x2 __attribute__((ext_vector_type(2)));
typedef _Float16 f16x8 __attribute__((ext_vector_type(8)));

constexpr int M = 16384, D = 1024, FF = 2816, SEQ = 8192, NFFT = 16384;
constexpr float ALPHA = 1.1892071150027210667f;
constexpr float LN_EPS = 1e-5f;
constexpr int NTHR = 512, NWAVES = 8;
constexpr int LDS_BYTES = 147456;
constexpr int NPHASE = 13;

constexpr size_t MiB = 1u << 20;
constexpr size_t WS_RPB = 65536;
constexpr size_t WS_PART = 1 * MiB;
constexpr size_t WS_W13A = 8 * MiB, WS_W2A = 19 * MiB, WS_WIN = 25 * MiB, WS_WPA = 35 * MiB, WS_WPB = 36 * MiB, WS_WOUT = 37 * MiB, WS_W13B = 39 * MiB, WS_W2B = 50 * MiB;
constexpr size_t WS_XB = 56 * MiB;
constexpr size_t WS_H = 88 * MiB;
constexpr size_t WS_Q = 88 * MiB, WS_K = 104 * MiB, WS_VT = 120 * MiB, WS_KC = 136 * MiB;
constexpr size_t WS_GATE = 104 * MiB;
constexpr size_t WS_UT = 176 * MiB;
constexpr size_t WS_YB = 192 * MiB;
constexpr size_t WS_KT = 224 * MiB;
constexpr size_t WS_MIX = 224 * MiB;
constexpr size_t WS_END = 256 * MiB;

struct Args { const float* in[29]; float* out; unsigned char* ws; int ph_lo, ph_hi; };

typedef __bf16 bf16x2_t __attribute__((ext_vector_type(2)));
__device__ __forceinline__ unsigned pkbf(float lo, float hi) { const f32x2 v = {lo, hi}; const bf16x2_t b = __builtin_convertvector(v, bf16x2_t); return __builtin_bit_cast(unsigned, b); }
__device__ __forceinline__ float bf2f(unsigned short b) { return __uint_as_float(((unsigned)b) << 16); }
__device__ __forceinline__ int opaque(int v) { asm volatile("" : "+v"(v)); return v; }
__device__ __forceinline__ float wave_sum(float v) {
#pragma unroll
    for (int o = 1; o < 64; o <<= 1) v += __shfl_xor(v, o);
    return v;
}

using pg8::Unit;
struct EpiSwiglu {
    static constexpr bool PERM = true, AFTER_DRAIN = false;
    bf16* H;
    __device__ __forceinline__ void operator()(const f32x4 (&acc)[2][2][4][2], const Unit& u, int wr, int wc, int fr, int fq) const {
        const int row0 = u.pm * 256 + wr * 64 + fr, col0 = u.pn * 128 + wc * 32 + 8 * fq;
#pragma unroll
        for (int ai = 0; ai < 2; ++ai)
#pragma unroll
            for (int m = 0; m < 4; ++m) {
                float o[8];
#pragma unroll
                for (int n = 0; n < 2; ++n)
#pragma unroll
                    for (int e = 0; e < 4; ++e) { const float a = acc[ai][0][m][n][e], b = acc[ai][1][m][n][e];
                        const float sg = __builtin_amdgcn_rcpf(1.0f + __builtin_amdgcn_exp2f(-1.4426950408889634f * a)); o[n * 4 + e] = a * sg * b; }
                u32x4 w; w.x = pkbf(o[0], o[1]); w.y = pkbf(o[2], o[3]); w.z = pkbf(o[4], o[5]); w.w = pkbf(o[6], o[7]);
                *(u32x4*)(H + (size_t)(row0 + ai * 128 + m * 16) * FF + col0) = w;
            }
    }
};
struct EpiResid {
    static constexpr bool PERM = false, AFTER_DRAIN = false;
    const float* resid; float* out; float s;
    __device__ __forceinline__ void operator()(const f32x4 (&acc)[2][2][4][2], const Unit& u, int wr, int wc, int fr, int fq) const {
        const int row0 = u.pm * 256 + wr * 64 + fr, col0 = u.pn * 256 + wc * 32 + 4 * fq;
#pragma unroll
        for (int ai = 0; ai < 2; ++ai)
#pragma unroll
            for (int m = 0; m < 4; ++m) { const size_t off = (size_t)(row0 + ai * 128 + m * 16) * D + col0;
#pragma unroll
                for (int bj = 0; bj < 2; ++bj)
#pragma unroll
                    for (int n = 0; n < 2; ++n) { const f32x4 rv = *(const f32x4*)(resid + off + bj * 128 + n * 16);
                        *(f32x4*)(out + off + bj * 128 + n * 16) = rv * ALPHA + acc[ai][bj][m][n] * s; } }
    }
};
struct EpiIn {
    static constexpr bool PERM = true, AFTER_DRAIN = false;
    bf16* Q; bf16* Kb; bf16* Vt; f16* uT;
    __device__ __forceinline__ void operator()(const f32x4 (&acc)[2][2][4][2], const Unit& u, int wr, int wc, int fr, int fq) const {
        const int row0 = u.pm * 256 + wr * 64 + fr;
        if (u.pn < 4) {
            bf16* base = (u.pn < 2) ? Q : Kb; const float sc = (u.pn < 2) ? 0.125f : 1.0f; const int col0 = (u.pn & 1) * 256 + wc * 32 + 8 * fq;
#pragma unroll
            for (int ai = 0; ai < 2; ++ai)
#pragma unroll
                for (int m = 0; m < 4; ++m)
#pragma unroll
                    for (int bj = 0; bj < 2; ++bj) { const f32x4 v0 = acc[ai][bj][m][0] * sc, v1 = acc[ai][bj][m][1] * sc;
                        u32x4 w; w.x = pkbf(v0[0], v0[1]); w.y = pkbf(v0[2], v0[3]); w.z = pkbf(v1[0], v1[1]); w.w = pkbf(v1[2], v1[3]);
                        *(u32x4*)(base + (size_t)(row0 + ai * 128 + m * 16) * 512 + col0 + bj * 128) = w; }
        } else if (u.pn < 6) {
            const int b = row0 >> 13, t0 = row0 & 8191, vc0 = (u.pn - 4) * 256 + wc * 32 + 8 * fq;
#pragma unroll
            for (int ai = 0; ai < 2; ++ai)
#pragma unroll
                for (int m = 0; m < 4; ++m)
#pragma unroll
                    for (int bj = 0; bj < 2; ++bj)
#pragma unroll
                        for (int n = 0; n < 2; ++n)
#pragma unroll
                            for (int e = 0; e < 4; ++e)
                                Vt[(((size_t)(b * 512 + vc0 + bj * 128 + n * 4 + e)) << 13) + t0 + ai * 128 + m * 16] = (bf16)(pkbf(acc[ai][bj][m][n][e], 0.f) & 0xffffu);
        } else {
            const int uc0 = (u.pn - 6) * 256 + wc * 32 + 8 * fq;
#pragma unroll
            for (int ai = 0; ai < 2; ++ai)
#pragma unroll
                for (int m = 0; m < 4; ++m)
#pragma unroll
                    for (int bj = 0; bj < 2; ++bj)
#pragma unroll
                        for (int n = 0; n < 2; ++n)
#pragma unroll
                            for (int e = 0; e < 4; ++e)
                                uT[(size_t)(uc0 + bj * 128 + n * 4 + e) * M + row0 + ai * 128 + m * 16] = (f16)acc[ai][bj][m][n][e];
        }
    }
};
struct EpiGate {
    static constexpr bool PERM = true, AFTER_DRAIN = false;
    bf16* G; const float* bg;
    __device__ __forceinline__ void operator()(const f32x4 (&acc)[2][2][4][2], const Unit& u, int wr, int wc, int fr, int fq) const {
        const int row0 = u.pm * 256 + wr * 64 + fr, col0 = u.pn * 256 + wc * 32 + 8 * fq;
#pragma unroll
        for (int bj = 0; bj < 2; ++bj) { const f32x4 b0 = *(const f32x4*)(bg + col0 + bj * 128), b1 = *(const f32x4*)(bg + col0 + bj * 128 + 4);
#pragma unroll
            for (int ai = 0; ai < 2; ++ai)
#pragma unroll
                for (int m = 0; m < 4; ++m) { float o[8];
#pragma unroll
                    for (int e = 0; e < 4; ++e) { o[e] = __builtin_amdgcn_rcpf(1.0f + __builtin_amdgcn_exp2f(-1.4426950408889634f * (acc[ai][bj][m][0][e] + b0[e])));
                                                  o[4 + e] = __builtin_amdgcn_rcpf(1.0f + __builtin_amdgcn_exp2f(-1.4426950408889634f * (acc[ai][bj][m][1][e] + b1[e]))); }
                    u32x4 w; w.x = pkbf(o[0], o[1]); w.y = pkbf(o[2], o[3]); w.z = pkbf(o[4], o[5]); w.w = pkbf(o[6], o[7]);
                    *(u32x4*)(G + (size_t)(row0 + ai * 128 + m * 16) * 2048 + col0 + bj * 128) = w; } }
    }
};
template <int SECOND> struct EpiMix {
    static constexpr bool PERM = true, AFTER_DRAIN = false;
    bf16* X; const bf16* G;
    __device__ __forceinline__ void operator()(const f32x4 (&acc)[2][2][4][2], const Unit& u, int wr, int wc, int fr, int fq) const {
        const int row0 = u.pm * 256 + wr * 64 + fr, col0 = u.pn * 256 + wc * 32 + 8 * fq;
#pragma unroll
        for (int ai = 0; ai < 2; ++ai)
#pragma unroll
            for (int m = 0; m < 4; ++m)
#pragma unroll
                for (int bj = 0; bj < 2; ++bj) { const size_t r = (size_t)(row0 + ai * 128 + m * 16);
                    const u32x4 g = *(const u32x4*)(G + r * 2048 + SECOND * 1024 + col0 + bj * 128);
                    u32x4 p = {0u, 0u, 0u, 0u}; if (SECOND) p = *(const u32x4*)(X + r * D + col0 + bj * 128);
                    float o[8];
#pragma unroll
                    for (int j = 0; j < 4; ++j) { const unsigned gw = g[j], pw = p[j]; const float a0 = acc[ai][bj][m][j >> 1][(j & 1) * 2], a1 = acc[ai][bj][m][j >> 1][(j & 1) * 2 + 1];
                        o[2 * j] = __uint_as_float(gw << 16) * a0 + __uint_as_float(pw << 16); o[2 * j + 1] = __uint_as_float(gw & 0xffff0000u) * a1 + __uint_as_float(pw & 0xffff0000u); }
                    u32x4 w; w.x = pkbf(o[0], o[1]); w.y = pkbf(o[2], o[3]); w.z = pkbf(o[4], o[5]); w.w = pkbf(o[6], o[7]);
                    *(u32x4*)(X + r * D + col0 + bj * 128) = w; }
    }
};
__device__ __forceinline__ void p0_transpose_item(const float* W, int K, int N, bf16* WT, int mode, int row_off, LAS float* scr, int item, int lane) {
    const int nblk = N / 32, kb = item / nblk, nb = item % nblk, k0 = 64 * kb, n0 = 32 * nb;
#pragma unroll 8
    for (int i = 0; i < 32; ++i) { const int kk = 2 * i + (lane >> 5); scr[kk * 33 + (lane & 31)] = W[(size_t)(k0 + kk) * N + n0 + (lane & 31)]; }
    asm volatile("s_waitcnt lgkmcnt(0)" ::: "memory");
    const int drow0 = mode ? ((n0 >> 7) * 256 + (n0 & 127) + row_off) : (row_off + n0);
    const int c = lane & 7;
#pragma unroll
    for (int j = 0; j < 4; ++j) { const int n = (lane >> 3) + 8 * j; const LAS float* s = scr + (8 * c) * 33 + n;
        u32x4 o; o.x = pkbf(s[0 * 33], s[1 * 33]); o.y = pkbf(s[2 * 33], s[3 * 33]); o.z = pkbf(s[4 * 33], s[5 * 33]); o.w = pkbf(s[6 * 33], s[7 * 33]);
        *(u32x4*)(WT + (size_t)(drow0 + n) * K + k0 + 8 * c) = o; }
    asm volatile("s_waitcnt lgkmcnt(0)" ::: "memory");
}

__device__ __forceinline__ void filter_tile(const Args& A, LAS unsigned char* lds, int tile, int tid) {
    const float* fw1 = A.in[11]; const float* fb1 = A.in[12]; const float* fw2 = A.in[13]; const float* fb2 = A.in[14];
    const float* fw3 = A.in[15]; const float* fb3 = A.in[16]; const float* freq = A.in[17];
    LAS float* zf = (LAS float*)lds;
    LAS float* h1 = zf + 33 * 33 + 3;
    LAS float* h2 = h1 + 33 * 64;
    const int t0 = tile * 32;
#pragma unroll 1
    for (int idx = tid; idx < 33 * 16; idx += NTHR) { const int tt = idx >> 4, f = idx & 15, i = t0 + tt;
        const float fj = 1e-4f + (float)f * ((15.0f - 1e-4f) / 15.0f), w = (6.283185307179586f / 8192.0f) * (float)i;
        const float s = __sinf(fj * w), c = __cosf(fj * w);
        zf[tt * 33 + 1 + f] = c; zf[tt * 33 + 17 + f] = -s; if (f == 0) zf[tt * 33] = (float)i * (1.0f / 8191.0f); }
    __syncthreads();
#pragma unroll 1
    for (int idx = tid; idx < 33 * 64; idx += NTHR) { const int tt = idx >> 6, o = idx & 63; float a = fb1[o];
#pragma unroll 1
        for (int f = 0; f < 33; ++f) a += zf[tt * 33 + f] * fw1[f * 64 + o];
        h1[tt * 64 + o] = __sinf(freq[o] * a); }
    __syncthreads();
#pragma unroll 1
    for (int idx = tid; idx < 33 * 64; idx += NTHR) { const int tt = idx >> 6, o = idx & 63; float a = fb2[o];
#pragma unroll 4
        for (int j = 0; j < 64; ++j) a += h1[tt * 64 + j] * fw2[j * 64 + o];
        h2[tt * 64 + o] = __sinf(freq[o] * a); }
    __syncthreads();
    const float dmin = 3.0701134573253945f, dmax = 15.350567286626973f;
    LAS f16* tl = (LAS f16*)(lds + 24576);
    float* part = (float*)(A.ws + WS_PART);
    f16* kT = (f16*)(A.ws + WS_KT);
#pragma unroll 1
    for (int dir = 0; dir < 2; ++dir) {
        const int col0 = dir * 1024 + tid * 2, c0 = col0 & 511;
        float acc[32][2];
#pragma unroll
        for (int tt = 0; tt < 32; ++tt) { acc[tt][0] = 0.f; acc[tt][1] = 0.f; }
        const LAS float* h2d = h2 + dir * 64;
#pragma unroll 1
        for (int j = 0; j < 64; j += 4) {
            const f32x2 w0 = *(const f32x2*)(fw3 + (size_t)(j + 0) * 2048 + col0), w1 = *(const f32x2*)(fw3 + (size_t)(j + 1) * 2048 + col0),
                        w2 = *(const f32x2*)(fw3 + (size_t)(j + 2) * 2048 + col0), w3 = *(const f32x2*)(fw3 + (size_t)(j + 3) * 2048 + col0);
#pragma unroll
            for (int tt = 0; tt < 32; ++tt) { const f32x4 hv = *(const LAS f32x4*)(h2d + tt * 64 + j);
#pragma unroll
                for (int c = 0; c < 2; ++c) acc[tt][c] += hv[0] * w0[c] + hv[1] * w1[c] + hv[2] * w2[c] + hv[3] * w3[c]; }
        }
        const f32x2 b3 = *(const f32x2*)(fb3 + col0);
        const float d0 = dmin + (float)(c0) * ((dmax - dmin) / 511.0f), d1 = dmin + (float)(c0 + 1) * ((dmax - dmin) / 511.0f);
        float ss0 = 0.f, ss1 = 0.f;
#pragma unroll
        for (int tt = 0; tt < 32; ++tt) { const int i = t0 + tt + dir; const float tl_ = (float)i * (1.0f / 8191.0f);
            float v0 = (acc[tt][0] + b3[0]) * __expf(-tl_ * d0), v1 = (acc[tt][1] + b3[1]) * __expf(-tl_ * d1); if (i >= 8192) { v0 = 0.f; v1 = 0.f; }
            ss0 += v0 * v0; ss1 += v1 * v1;
            tl[(tid * 2) * 34 + tt] = (f16)v0; tl[(tid * 2 + 1) * 34 + tt] = (f16)v1; }
        *(f32x2*)(part + (size_t)tile * 2048 + col0) = (f32x2){ss0, ss1};
        __syncthreads();
#pragma unroll 1
        for (int it = 0; it < 8; ++it) { const int chunk = it * NTHR + opaque(tid), row = chunk >> 2, p = chunk & 3;
            f16x8 o;
            if (dir == 0) {
#pragma unroll
                for (int e = 0; e < 8; ++e) o[e] = tl[row * 34 + p * 8 + e];
                *(f16x8*)(kT + (size_t)row * NFFT + t0 + p * 8) = o;
            } else {
#pragma unroll
                for (int e = 0; e < 8; ++e) o[e] = tl[row * 34 + 31 - p * 8 - e];
                *(f16x8*)(kT + (size_t)row * NFFT + (NFFT - t0 - 32) + p * 8) = o;
            }
        }
        __syncthreads();
    }
}

__device__ __forceinline__ void p0_prologue(const Args& A, LAS unsigned char* lds, int tid, int lane, int wave) {
    unsigned char* ws = A.ws;
    LAS float* scr = (LAS float*)(lds + wave * 16384);
    const int gw = blockIdx.x * NWAVES + wave, NGW = gridDim.x * NWAVES;
    constexpr int I_UP = (D / 64) * (FF / 32), I_DN = (FF / 64) * (D / 32), I_IN = (D / 64) * (5120 / 32), I_P = (512 / 64) * (D / 32), I_O = (D / 64) * (D / 32);
    constexpr int NITEMS = 6 * I_UP   + I_IN + 2 * I_P + I_O;
    static_assert(I_UP == I_DN, "item counts");
    for (int it = gw; it < NITEMS; it += NGW) {
        int r = it;
        if (r < I_UP) { p0_transpose_item(A.in[3], D, FF, (bf16*)(ws + WS_W13A), 1, 0, scr, r, lane); continue; } r -= I_UP;
        if (r < I_UP) { p0_transpose_item(A.in[4], D, FF, (bf16*)(ws + WS_W13A), 1, 128, scr, r, lane); continue; } r -= I_UP;
        if (r < I_DN) { p0_transpose_item(A.in[5], FF, D, (bf16*)(ws + WS_W2A), 0, 0, scr, r, lane); continue; } r -= I_DN;
        if (r < I_IN) { p0_transpose_item(A.in[6], D, 5120, (bf16*)(ws + WS_WIN), 0, 0, scr, r, lane); continue; } r -= I_IN;
        if (r < I_P) { p0_transpose_item(A.in[19], 512, D, (bf16*)(ws + WS_WPA), 0, 0, scr, r, lane); continue; } r -= I_P;
        if (r < I_P) { p0_transpose_item(A.in[20], 512, D, (bf16*)(ws + WS_WPB), 0, 0, scr, r, lane); continue; } r -= I_P;
        if (r < I_O) { p0_transpose_item(A.in[21], D, D, (bf16*)(ws + WS_WOUT), 0, 0, scr, r, lane); continue; } r -= I_O;
        if (r < I_UP) { p0_transpose_item(A.in[24], D, FF, (bf16*)(ws + WS_W13B), 1, 0, scr, r, lane); continue; } r -= I_UP;
        if (r < I_UP) { p0_transpose_item(A.in[25], D, FF, (bf16*)(ws + WS_W13B), 1, 128, scr, r, lane); continue; } r -= I_UP;
        p0_transpose_item(A.in[26], FF, D, (bf16*)(ws + WS_W2B), 0, 0, scr, r, lane);
    }
    if (blockIdx.x == 0) { float* rp = (float*)(ws + WS_RPB); for (int i = tid; i < 8 * 15 * 48; i += NTHR) { const int col = i % 48 - 8; rp[i] = (col >= 0 && col < 31) ? A.in[8][(i / 48) * 31 + col] : 0.f; } }
    { const f32x4* x4 = (const f32x4*)A.in[0]; u32x4* o4 = (u32x4*)(ws + WS_XB);
      for (size_t i = (size_t)blockIdx.x * NTHR + tid; i < (size_t)M * D / 8; i += (size_t)gridDim.x * NTHR) { const f32x4 a = x4[2 * i], b = x4[2 * i + 1];
          u32x4 w; w.x = pkbf(a[0], a[1]); w.y = pkbf(a[2], a[3]); w.z = pkbf(b[0], b[1]); w.w = pkbf(b[2], b[3]); o4[i] = w; } }
    __syncthreads();
    for (int pr = blockIdx.x; pr < 128; pr += gridDim.x) { filter_tile(A, lds, 2 * pr, tid); filter_tile(A, lds, 2 * pr + 1, tid); }
}

__device__ __forceinline__ void ln_phase(const float* src, float* dst, bf16* xb, const float* g, const float* b, int lane, int wave) {
    const int gw = blockIdx.x * NWAVES + wave, NGW = gridDim.x * NWAVES;
    f32x4 gv[4], bv[4];
#pragma unroll
    for (int j = 0; j < 4; ++j) { gv[j] = ((const f32x4*)g)[lane + 64 * j]; bv[j] = ((const f32x4*)b)[lane + 64 * j]; }
    for (int m = gw; m < M; m += NGW) {
        const f32x4* xr = (const f32x4*)(src + (size_t)m * D) + lane;
        f32x4 v[4]; float s = 0.f;
#pragma unroll
        for (int j = 0; j < 4; ++j) { v[j] = xr[64 * j]; s += (v[j][0] + v[j][1]) + (v[j][2] + v[j][3]); }
        const float mean = wave_sum(s) * (1.f / D); float s2 = 0.f;
#pragma unroll
        for (int j = 0; j < 4; ++j) { v[j] = v[j] - mean; s2 += (v[j][0] * v[j][0] + v[j][1] * v[j][1]) + (v[j][2] * v[j][2] + v[j][3] * v[j][3]); }
        const float rstd = 1.0f / sqrtf(wave_sum(s2) * (1.f / D) + LN_EPS);
        f32x4* orow = (f32x4*)(dst + (size_t)m * D) + lane;
#pragma unroll
        for (int j = 0; j < 4; ++j) { const f32x4 o = v[j] * rstd * gv[j] + bv[j]; orow[64 * j] = o;
            if (xb) { u32x2 w; w.x = pkbf(o[0], o[1]); w.y = pkbf(o[2], o[3]); ((u32x2*)(xb + (size_t)m * D))[lane + 64 * j] = w; } }
    }
}
typedef f32x2 cplx;
__device__ __forceinline__ cplx cmul(cplx a, cplx b) { return (cplx){a[0] * b[0] - a[1] * b[1], a[0] * b[1] + a[1] * b[0]}; }
__device__ __forceinline__ cplx cmulc(cplx a, cplx b) { return (cplx){a[0] * b[0] + a[1] * b[1], a[1] * b[0] - a[0] * b[1]}; }
__device__ __forceinline__ int swz(int i) { return i ^ ((i >> 5) & 3) ^ (((i >> 6) & 7) << 2); }
__device__ __forceinline__ cplx twd(const LAS cplx* T1, const LAS cplx* T2, int e) { return cmul(T1[e >> 7], T2[e & 127]); }
__device__ __forceinline__ void bfly_f(cplx& a0, cplx& a1, cplx& a2, cplx& a3) {
    const cplx t0 = a0 + a2, t1 = a0 - a2, t2 = a1 + a3, d = a1 - a3; const cplx t3 = (cplx){d[1], -d[0]};
    a0 = t0 + t2; a1 = t1 + t3; a2 = t0 - t2; a3 = t1 - t3;
}
__device__ __forceinline__ void bfly_i(cplx& a0, cplx& a1, cplx& a2, cplx& a3) {
    const cplx t0 = a0 + a2, t1 = a0 - a2, t2 = a1 + a3, d = a1 - a3; const cplx t3 = (cplx){-d[1], d[0]};
    a0 = t0 + t2; a1 = t1 + t3; a2 = t0 - t2; a3 = t1 - t3;
}
template <int LQ> __device__ __forceinline__ void fwd16(cplx (&r)[16], int j0, const LAS cplx* T1, const LAS cplx* T2) {
    constexpr int SA = 10 - LQ;
#pragma unroll
    for (int c = 0; c < 4; ++c) {
        bfly_f(r[c], r[c + 4], r[c + 8], r[c + 12]);
        const cplx w1 = twd(T1, T2, (j0 + (c << LQ)) << SA), w2 = cmul(w1, w1), w3 = cmul(w1, w2);
        r[c + 4] = cmul(r[c + 4], w1); r[c + 8] = cmul(r[c + 8], w2); r[c + 12] = cmul(r[c + 12], w3);
    }
    const cplx v1 = twd(T1, T2, j0 << (SA + 2)), v2 = cmul(v1, v1), v3 = cmul(v1, v2);
#pragma unroll
    for (int m = 0; m < 4; ++m) {
        bfly_f(r[4 * m], r[4 * m + 1], r[4 * m + 2], r[4 * m + 3]);
        r[4 * m + 1] = cmul(r[4 * m + 1], v1); r[4 * m + 2] = cmul(r[4 * m + 2], v2); r[4 * m + 3] = cmul(r[4 * m + 3], v3);
    }
}
template <int LQ> __device__ __forceinline__ void inv16(cplx (&r)[16], int j0, const LAS cplx* T1, const LAS cplx* T2) {
    constexpr int SA = 10 - LQ;
    const cplx v1 = twd(T1, T2, j0 << (SA + 2)), v2 = cmul(v1, v1), v3 = cmul(v1, v2);
#pragma unroll
    for (int m = 0; m < 4; ++m) {
        r[4 * m + 1] = cmulc(r[4 * m + 1], v1); r[4 * m + 2] = cmulc(r[4 * m + 2], v2); r[4 * m + 3] = cmulc(r[4 * m + 3], v3);
        bfly_i(r[4 * m], r[4 * m + 1], r[4 * m + 2], r[4 * m + 3]);
    }
#pragma unroll
    for (int c = 0; c < 4; ++c) {
        const cplx w1 = twd(T1, T2, (j0 + (c << LQ)) << SA), w2 = cmul(w1, w1), w3 = cmul(w1, w2);
        r[c + 4] = cmulc(r[c + 4], w1); r[c + 8] = cmulc(r[c + 8], w2); r[c + 12] = cmulc(r[c + 12], w3);
        bfly_i(r[c], r[c + 4], r[c + 8], r[c + 12]);
    }
}
template <int LQ, bool INV> __device__ __forceinline__ void lds_pass16(LAS cplx* Z, const LAS cplx* T1, const LAS cplx* T2, int tid) {
#pragma unroll 1
    for (int h = 0; h < 2; ++h) { const int s = opaque(tid) + h * NTHR, j0 = s & ((1 << LQ) - 1), g = (s >> LQ) << (LQ + 4);
        cplx r[16];
#pragma unroll
        for (int k = 0; k < 16; ++k) r[k] = Z[swz(g + j0 + (k << LQ))];
        if (INV) inv16<LQ>(r, j0, T1, T2); else fwd16<LQ>(r, j0, T1, T2);
#pragma unroll
        for (int k = 0; k < 16; ++k) Z[swz(g + j0 + (k << LQ))] = r[k];
    }
}
__device__ __forceinline__ float block_sum(float v, LAS float* red, int tid) {
    v = wave_sum(v); __syncthreads(); if ((tid & 63) == 0) red[tid >> 6] = v; __syncthreads();
    float s = 0.f;
#pragma unroll
    for (int i = 0; i < NWAVES; ++i) s += red[i];
    return s;
}
__device__ __forceinline__ float short_conv(const f16* uT, const float* sw, const float* sb, int ch, int b, int t) {
    const f16* p = uT + (size_t)ch * M + b * SEQ + t;
    const float um = t > 0 ? (float)p[-1] : 0.f, u0 = (float)p[0], up = t < SEQ - 1 ? (float)p[1] : 0.f;
    return sb[ch] + sw[ch] * um + sw[1536 + ch] * u0 + sw[3072 + ch] * up;
}

__device__ __forceinline__ void hyena_channel(const Args& A, LAS unsigned char* lds, int c, int tid) {
    LAS cplx* Z = (LAS cplx*)lds; const LAS cplx* T1 = (const LAS cplx*)(lds + 131072); const LAS cplx* T2 = T1 + 128; LAS float* red = (LAS float*)(lds + 131072 + 2048);
    f16* uT = (f16*)(A.ws + WS_UT); const f16* kT = (const f16*)(A.ws + WS_KT); const float* part = (const float*)(A.ws + WS_PART);
    const float* sw = A.in[9]; const float* sb = A.in[10]; const float* hb = A.in[18];
    unsigned long long* KC = (unsigned long long*)(A.ws + WS_KC) + (size_t)blockIdx.x * NFFT;
    float zr[2][8][2];
    { const float v_b = sb[c], v_w0 = sw[c], v_w1 = sw[1536 + c], v_w2 = sw[3072 + c];
#pragma unroll
    for (int h = 0; h < 2; ++h)
#pragma unroll
        for (int k = 0; k < 8; ++k) {
#pragma unroll
            for (int b = 0; b < 2; ++b) { const int t = tid + h * NTHR + 1024 * k; const f16* p = uT + (size_t)c * M + b * SEQ + t;
                const float um = t > 0 ? (float)p[-1] : 0.f, u0 = (float)p[0], up = t < SEQ - 1 ? (float)p[1] : 0.f;
                zr[h][k][b] = v_b + v_w0 * um + v_w1 * u0 + v_w2 * up; }
            if ((k & 1) == 1) __builtin_amdgcn_sched_barrier(0); } }
#pragma unroll 1
    for (int n = 0; n < 2; ++n) {
        const float ssq = block_sum(part[(size_t)(tid >> 1) * 2048 + (tid & 1) * 1024 + n * 512 + c], red, tid);
        const float kscale = 1.0f / sqrtf(ssq + 1e-12f);
        const f16* kr = kT + (size_t)(n * 512 + c) * NFFT;
#ifndef SK1
#pragma unroll 1
        for (int h = 0; h < 2; ++h) { const int j0 = opaque(tid) + h * NTHR; cplx r[16];
#pragma unroll
            for (int k = 0; k < 16; ++k) r[k] = (cplx){(float)kr[j0 + 1024 * k] * kscale, 0.f};
            fwd16<10>(r, j0, T1, T2);
#pragma unroll
            for (int k = 0; k < 16; ++k) Z[swz(j0 + 1024 * k)] = r[k]; }
#endif
        __syncthreads();
#ifndef SK2
        lds_pass16<6, false>(Z, T1, T2, tid); __syncthreads();
        lds_pass16<2, false>(Z, T1, T2, tid); __syncthreads();
#endif
#pragma unroll 1
        for (int it = 0; it < 8; ++it) { const int bf = it * NTHR + opaque(tid);
            cplx a0 = Z[swz(4 * bf)], a1 = Z[swz(4 * bf + 1)], a2 = Z[swz(4 * bf + 2)], a3 = Z[swz(4 * bf + 3)];
            bfly_f(a0, a1, a2, a3);
            f32x4* o = (f32x4*)(KC + 4 * bf); o[0] = (f32x4){a0[0], a0[1], a1[0], a1[1]}; o[1] = (f32x4){a2[0], a2[1], a3[0], a3[1]}; }
        asm volatile("s_waitcnt vmcnt(0)" ::: "memory");
        __syncthreads();
#pragma unroll 1
        for (int h = 0; h < 2; ++h) { const int j0 = opaque(tid) + h * NTHR; cplx r[16];
#pragma unroll
            for (int k = 0; k < 8; ++k) { r[k] = h ? (cplx){zr[1][k][0], zr[1][k][1]} : (cplx){zr[0][k][0], zr[0][k][1]}; r[k + 8] = (cplx){0.f, 0.f}; }
            fwd16<10>(r, j0, T1, T2);
#pragma unroll
            for (int k = 0; k < 16; ++k) Z[swz(j0 + 1024 * k)] = r[k];
            __builtin_amdgcn_sched_barrier(0); }
        __syncthreads();
        lds_pass16<6, false>(Z, T1, T2, tid); __syncthreads();
        lds_pass16<2, false>(Z, T1, T2, tid); __syncthreads();
#pragma unroll 1
        for (int it = 0; it < 8; ++it) { const int bf = it * NTHR + opaque(tid);
            cplx a0 = Z[swz(4 * bf)], a1 = Z[swz(4 * bf + 1)], a2 = Z[swz(4 * bf + 2)], a3 = Z[swz(4 * bf + 3)];
            bfly_f(a0, a1, a2, a3);
            unsigned long long k0 = __hip_atomic_load(KC + 4 * bf, __ATOMIC_RELAXED, __HIP_MEMORY_SCOPE_AGENT), k1 = __hip_atomic_load(KC + 4 * bf + 1, __ATOMIC_RELAXED, __HIP_MEMORY_SCOPE_AGENT),
                               k2 = __hip_atomic_load(KC + 4 * bf + 2, __ATOMIC_RELAXED, __HIP_MEMORY_SCOPE_AGENT), k3 = __hip_atomic_load(KC + 4 * bf + 3, __ATOMIC_RELAXED, __HIP_MEMORY_SCOPE_AGENT);
            a0 = cmul(a0, (cplx){__uint_as_float((unsigned)k0), __uint_as_float((unsigned)(k0 >> 32))});
            a1 = cmul(a1, (cplx){__uint_as_float((unsigned)k1), __uint_as_float((unsigned)(k1 >> 32))});
            a2 = cmul(a2, (cplx){__uint_as_float((unsigned)k2), __uint_as_float((unsigned)(k2 >> 32))});
            a3 = cmul(a3, (cplx){__uint_as_float((unsigned)k3), __uint_as_float((unsigned)(k3 >> 32))});
            bfly_i(a0, a1, a2, a3);
            Z[swz(4 * bf)] = a0; Z[swz(4 * bf + 1)] = a1; Z[swz(4 * bf + 2)] = a2; Z[swz(4 * bf + 3)] = a3; }
        __syncthreads();
        lds_pass16<2, true>(Z, T1, T2, tid); __syncthreads();
        lds_pass16<6, true>(Z, T1, T2, tid); __syncthreads();
        const float bias = hb[n * 512 + c];
        const int gch = (n + 1) * 512 + c;
        const float g_b = sb[gch], g_w0 = sw[gch], g_w1 = sw[1536 + gch], g_w2 = sw[3072 + gch];
#pragma unroll 1
        for (int h = 0; h < 2; ++h) { const int j0 = opaque(tid) + h * NTHR; cplx r[16];
#pragma unroll
            for (int k = 0; k < 16; ++k) r[k] = Z[swz(j0 + 1024 * k)];
            inv16<10>(r, j0, T1, T2);
            __builtin_amdgcn_sched_barrier(0);
#pragma unroll
            for (int k = 0; k < 8; ++k) {
#pragma unroll
                for (int b = 0; b < 2; ++b) { const int t = j0 + 1024 * k; const f16* p = uT + (size_t)gch * M + b * SEQ + t;
                    const float um = t > 0 ? (float)p[-1] : 0.f, u0 = (float)p[0], up = t < SEQ - 1 ? (float)p[1] : 0.f;
                    const float gate = g_b + g_w0 * um + g_w1 * u0 + g_w2 * up;
                    const float zo = h ? zr[1][k][b] : zr[0][k][b]; const float zn = gate * (r[k][b] * (1.0f / NFFT) + bias * zo);
                    if (h) zr[1][k][b] = zn; else zr[0][k][b] = zn; }
                if ((k & 1) == 1) __builtin_amdgcn_sched_barrier(0); }
        }
        __syncthreads();
    }
#pragma unroll
    for (int h = 0; h < 2; ++h)
#pragma unroll
        for (int k = 0; k < 8; ++k)
#pragma unroll
            for (int b = 0; b < 2; ++b) uT[(size_t)c * M + b * SEQ + tid + h * NTHR + 1024 * k] = (f16)zr[h][k][b];
}

__device__ __forceinline__ void na_unit(const Args& A, int u, int lane) {
    bf16* Q = (bf16*)(A.ws + WS_Q); const bf16* Kb = (const bf16*)(A.ws + WS_K); const bf16* Vt = (const bf16*)(A.ws + WS_VT); const float* rpbp = (const float*)(A.ws + WS_RPB);
    const int jq = u & 3, r = (u >> 2) & 127, hh = (u >> 9) & 7, b = u >> 12, fr = lane & 15, fq = lane >> 4;
    const int rs = min(max(r - 4, 0), 120), wb = min(max(16 * jq - 8, 0), 32), c = 16 * jq + fr, cs = min(max(c - 8, 0), 48);
    const size_t qrow = (size_t)b * SEQ + r * 64 + c;
    const bf16x8 q0 = *(const bf16x8*)(Q + qrow * 512 + hh * 64 + 8 * fq), q1 = *(const bf16x8*)(Q + qrow * 512 + hh * 64 + 32 + 8 * fq);
    const int krow = wb + 8 * (fr >> 2) + (fr & 3);
    const int dc0 = wb + 8 * fq - c + 15;
    float s[8][8]; float mx = -1e30f;
#pragma unroll
    for (int a = 0; a < 8; ++a) { const int dr = rs + a - r + 7;
        const float* bp = rpbp + (hh * 15 + dr) * 48 + dc0 + 8;
        const f32x4 bv0 = *(const f32x4*)bp, bv1 = *(const f32x4*)(bp + 4);
#pragma unroll
        for (int ct = 0; ct < 2; ++ct) { const size_t tok = (size_t)b * SEQ + (rs + a) * 64 + krow + 4 * ct;
            const bf16x8 k0 = *(const bf16x8*)(Kb + tok * 512 + hh * 64 + 8 * fq), k1 = *(const bf16x8*)(Kb + tok * 512 + hh * 64 + 32 + 8 * fq);
            f32x4 acc = {0.f, 0.f, 0.f, 0.f};
            acc = __builtin_amdgcn_mfma_f32_16x16x32_bf16(k0, q0, acc, 0, 0, 0); acc = __builtin_amdgcn_mfma_f32_16x16x32_bf16(k1, q1, acc, 0, 0, 0);
#pragma unroll
            for (int i = 0; i < 4; ++i) { const int kc = wb + 8 * fq + 4 * ct + i; const bool ok = (kc >= cs) && (kc < cs + 16);
                const float v = ok ? acc[i] + (ct ? bv1[i] : bv0[i]) : -1e30f; s[a][4 * ct + i] = v; mx = fmaxf(mx, v); } } }
    mx = fmaxf(mx, __shfl_xor(mx, 16)); mx = fmaxf(mx, __shfl_xor(mx, 32));
    float sum = 0.f;
#pragma unroll
    for (int a = 0; a < 8; ++a)
#pragma unroll
        for (int j = 0; j < 8; ++j) { const float p = __expf(s[a][j] - mx); s[a][j] = p; sum += p; }
    sum += __shfl_xor(sum, 16); sum += __shfl_xor(sum, 32);
    const float inv = 1.0f / sum;
    f32x4 o[4];
#pragma unroll
    for (int dt = 0; dt < 4; ++dt) o[dt] = (f32x4){0.f, 0.f, 0.f, 0.f};
#pragma unroll
    for (int a = 0; a < 8; ++a) {
        u32x4 pw; pw.x = pkbf(s[a][0], s[a][1]); pw.y = pkbf(s[a][2], s[a][3]); pw.z = pkbf(s[a][4], s[a][5]); pw.w = pkbf(s[a][6], s[a][7]);
        const bf16x8 pb = __builtin_bit_cast(bf16x8, pw);
#pragma unroll
        for (int dt = 0; dt < 4; ++dt) { const bf16* vp = Vt + (((size_t)(b * 512 + hh * 64 + 16 * dt + fr)) << 13) + (rs + a) * 64 + wb + 8 * fq;
            const bf16x8 vf = *(const bf16x8*)vp;
            o[dt] = __builtin_amdgcn_mfma_f32_16x16x32_bf16(vf, pb, o[dt], 0, 0, 0); } }
#pragma unroll
    for (int dt = 0; dt < 4; ++dt) { u32x2 w; w.x = pkbf(o[dt][0] * inv, o[dt][1] * inv); w.y = pkbf(o[dt][2] * inv, o[dt][3] * inv);
        *(u32x2*)(Q + qrow * 512 + hh * 64 + 16 * dt + 4 * fq) = w; }
}

__device__ __forceinline__ void transpose_yb(const Args& A, LAS unsigned char* lds, int tid) {
    const f16* ybT = (const f16*)(A.ws + WS_UT); bf16* yb = (bf16*)(A.ws + WS_YB); LAS float* tl = (LAS float*)lds;
    for (int tile = blockIdx.x; tile < 8 * 256; tile += gridDim.x) { const int c0 = (tile & 7) * 64, k0 = (tile >> 3) * 64;
        { const int ci = tid >> 3, tj = (tid & 7) * 8; const f16x8 v = *(const f16x8*)(ybT + (size_t)(c0 + ci) * M + k0 + tj);
#pragma unroll
          for (int e = 0; e < 8; ++e) tl[ci * 65 + tj + e] = (float)v[e]; }
        __syncthreads();
        { const int ti = tid >> 3, cj = (tid & 7) * 8; float o[8];
#pragma unroll
          for (int e = 0; e < 8; ++e) o[e] = tl[(cj + e) * 65 + ti];
          u32x4 w; w.x = pkbf(o[0], o[1]); w.y = pkbf(o[2], o[3]); w.z = pkbf(o[4], o[5]); w.w = pkbf(o[6], o[7]);
          *(u32x4*)(yb + (size_t)(k0 + ti) * 512 + c0 + cj) = w; }
        __syncthreads();
    }
}
#define XB_TMO      128
#define XB_XCNT(j)  (256  + 64 * (j))
#define XB_XSUB(j)  (1280 + 64 * (j))
#define XB_XGEN(j)  (2304 + 64 * (j))
#define XB_TOP      3328
#define XB_TOPGEN   3392
#define XCD_BAR_WORDS 3456
#define XB_SPIN_CAP (1u << 18)

__device__ __forceinline__ unsigned xb_ld(unsigned* p)              { return __hip_atomic_load(p, __ATOMIC_RELAXED, __HIP_MEMORY_SCOPE_AGENT); }
__device__ __forceinline__ unsigned xb_add(unsigned* p, unsigned v) { return __hip_atomic_fetch_add(p, v, __ATOMIC_RELAXED, __HIP_MEMORY_SCOPE_AGENT); }
__device__ __forceinline__ unsigned xb_xcc_id() { return (unsigned)__builtin_amdgcn_s_getreg((3 << 11) | 20) & 0xFu; }
#define XB_SPIN(cond, bar) do { unsigned _sp = 0; while (cond) { __builtin_amdgcn_s_sleep(1); \
    if ((++_sp & 255u) == 0u) { if (xb_ld(&(bar)[XB_TMO])) break; if (_sp > XB_SPIN_CAP) { atomicAdd(&(bar)[XB_TMO], 1u); break; } } } } while (0)

struct XcdBarrier {
    unsigned* bar; unsigned x;
    volatile LAS unsigned* st;
};

__device__ __forceinline__ XcdBarrier xcd_barrier_post(unsigned* bar, volatile LAS unsigned* st) {
    XcdBarrier b; b.bar = bar; b.x = xb_xcc_id(); b.st = st;
    if (threadIdx.x == 0) (void)xb_add(&bar[XB_XCNT(b.x)], 1u);
    return b;
}
__device__ __forceinline__ void xcd_barrier_complete(unsigned* bar, unsigned x, unsigned& nloc, unsigned& nx) {
    const unsigned G = gridDim.x * gridDim.y * gridDim.z;
    unsigned sum, cnt, mine, sp = 0u;
    for (;;) {
        sum = 0u; cnt = 0u; mine = 0u;
#pragma unroll
        for (unsigned j = 0; j < 16; ++j) { const unsigned c = xb_ld(&bar[XB_XCNT(j)]); sum += c; cnt += (c > 0u) ? 1u : 0u; mine = (j == x) ? c : mine; }
        if (sum == G) break;
        __builtin_amdgcn_s_sleep(1);
        if ((++sp & 255u) == 0u) { if (xb_ld(&bar[XB_TMO])) break; if (sp > XB_SPIN_CAP) { atomicAdd(&bar[XB_TMO], 1u); break; } }
    }
    nloc = mine > 0u ? mine : 1u; nx = cnt > 0u ? cnt : 1u;
}

__device__ __forceinline__ void xcd_barrier(const XcdBarrier& b) {
    asm volatile("s_waitcnt vmcnt(0)" ::: "memory");
    __syncthreads();
    if (threadIdx.x == 0) {
        unsigned* bar = b.bar;
        __builtin_amdgcn_s_waitcnt(0);
        unsigned nloc = b.st[0], nx = b.st[1];
        if (nloc == 0u) { xcd_barrier_complete(bar, b.x, nloc, nx); b.st[0] = nloc; b.st[1] = nx; }
        const unsigned old = xb_add(&bar[XB_XSUB(b.x)], 1u);
        const unsigned gen = old / nloc;
        if (old + 1u == (gen + 1u) * nloc) {
            __builtin_amdgcn_fence(__ATOMIC_RELEASE, "agent");
            asm volatile("s_waitcnt vmcnt(0)" ::: "memory");
            const unsigned og = xb_add(&bar[XB_TOP], 1u);
            const unsigned tg = og / nx;
            if (og + 1u == (tg + 1u) * nx) xb_add(&bar[XB_TOPGEN], 1u);
            else XB_SPIN(xb_ld(&bar[XB_TOPGEN]) == tg, bar);
            __builtin_amdgcn_fence(__ATOMIC_ACQUIRE, "agent");
            xb_add(&bar[XB_XGEN(b.x)], 1u);
            asm volatile("s_waitcnt vmcnt(0)" ::: "memory");
        } else {
            XB_SPIN(xb_ld(&bar[XB_XGEN(b.x)]) == gen, bar);
            __builtin_amdgcn_fence(__ATOMIC_ACQUIRE, "agent");
            asm volatile("s_waitcnt vmcnt(0)" ::: "memory");
        }
    }
    __syncthreads();
}

__global__ void __launch_bounds__(NTHR, 2) mk_fwd(Args A) {
    extern __shared__ __attribute__((aligned(16))) unsigned char lds_raw[];
    LAS unsigned char* lds = (LAS unsigned char*)lds_raw;
    const int tid = threadIdx.x, lane = tid & 63, wave = __builtin_amdgcn_readfirstlane(tid >> 6);
    cg::grid_group grid = cg::this_grid();
    if (tid < 2) ((volatile LAS unsigned*)(lds + 140000))[tid] = 0u;
    __syncthreads();
    XcdBarrier xbar = xcd_barrier_post((unsigned*)A.ws + 4096, (volatile LAS unsigned*)(lds + 140000));
    const int lo = A.ph_lo, hi = A.ph_hi, G = gridDim.x, bx = blockIdx.x;
    unsigned char* ws = A.ws;
#ifndef PMASK
#define PMASK 0x3fff
#endif
#define IN(k) (((PMASK >> (k)) & 1) && ((lo <= (k) && (k) < hi) || ((k) == 13 && lo <= 6 && hi >= 8) || (lo == 13 && (k) == 13)))
#define GSYNC() do { xcd_barrier(xbar); } while (0)
#define SEAM(k) do { if (IN(k) && IN((k) + 1)) GSYNC(); } while (0)
    bf16* XB = (bf16*)(ws + WS_XB); bf16* HB = (bf16*)(ws + WS_H); float* R = A.out;

    if (IN(0)) { p0_prologue(A, lds, tid, lane, wave); }
    SEAM(0);
    if (IN(1)) { pg8::Gemm g{XB, (const bf16*)(ws + WS_W13A), M, 2 * FF, D}; pg8::StaticOrder S; S.init(M, 2 * FF, G, bx); EpiSwiglu E{HB};
                 pg8::gemm_phase<EpiSwiglu, pg8::StaticOrder, true, true>(lds, g, S, E); } SEAM(1);
    if (IN(2)) { pg8::Gemm g{HB, (const bf16*)(ws + WS_W2A), M, D, FF}; pg8::StaticOrder S; S.init(M, D, G, bx); EpiResid E{A.in[0], R, 0.5f};
                 pg8::gemm_phase<EpiResid, pg8::StaticOrder, true, true>(lds, g, S, E); } SEAM(2);
    if (IN(3)) { ln_phase(R, R, XB, A.in[1], A.in[2], lane, wave); } SEAM(3);
    if (IN(4)) { pg8::Gemm g{XB, (const bf16*)(ws + WS_WIN), M, 3072, D}; pg8::StaticOrder S; S.init(M, 3072, G, bx);
                 EpiIn E{(bf16*)(ws + WS_Q), (bf16*)(ws + WS_K), (bf16*)(ws + WS_VT), (f16*)(ws + WS_UT)};
                 pg8::gemm_phase<EpiIn, pg8::StaticOrder, true, true>(lds, g, S, E); } SEAM(4);
    if (IN(5)) {
        if (tid < 256) { float s, c; const int k = tid & 127; sincospif(tid < 128 ? -(float)k * (1.0f / 64.0f) : -(float)k * (1.0f / 8192.0f), &s, &c);
            ((LAS cplx*)(lds + 131072))[tid] = (cplx){c, s}; }
        __syncthreads();
        #ifndef NO_HY
        for (int c = bx; c < 512; c += G) hyena_channel(A, lds, c, tid);
#endif
        #ifndef NO_NA
        for (int u = bx * NWAVES + wave; u < 8192; u += G * NWAVES) na_unit(A, u, lane);
#endif
    } SEAM(5);
    if (IN(6)) { transpose_yb(A, lds, tid); } SEAM(6);
    if (IN(13)) { pg8::Gemm g{XB, (const bf16*)(ws + WS_WIN) + (size_t)3072 * D, M, 2048, D}; pg8::StaticOrder S; S.init(M, 2048, G, bx); EpiGate E{(bf16*)(ws + WS_GATE), A.in[7]};
                  pg8::gemm_phase<EpiGate, pg8::StaticOrder, true, true>(lds, g, S, E); }
    if (IN(13) && IN(7)) GSYNC();
    if (IN(7)) { pg8::StaticOrder S; S.init(M, D, G, bx);
                 { pg8::Gemm g{(const bf16*)(ws + WS_Q), (const bf16*)(ws + WS_WPA), M, D, 512}; EpiMix<0> E{(bf16*)(ws + WS_MIX), (const bf16*)(ws + WS_GATE)};
                   pg8::gemm_phase<EpiMix<0>, pg8::StaticOrder, true, true>(lds, g, S, E); }
                 { pg8::Gemm g{(const bf16*)(ws + WS_YB), (const bf16*)(ws + WS_WPB), M, D, 512}; EpiMix<1> E{(bf16*)(ws + WS_MIX), (const bf16*)(ws + WS_GATE)};
                   pg8::gemm_phase<EpiMix<1>, pg8::StaticOrder, true, true>(lds, g, S, E); } } SEAM(7);
    if (IN(8)) { pg8::Gemm g{(const bf16*)(ws + WS_MIX), (const bf16*)(ws + WS_WOUT), M, D, D}; pg8::StaticOrder S; S.init(M, D, G, bx); EpiResid E{R, R, 1.0f};
                 pg8::gemm_phase<EpiResid, pg8::StaticOrder, true, true>(lds, g, S, E); } SEAM(8);
    if (IN(9)) { ln_phase(R, R, XB, A.in[22], A.in[23], lane, wave); } SEAM(9);
    if (IN(10)) { pg8::Gemm g{XB, (const bf16*)(ws + WS_W13B), M, 2 * FF, D}; pg8::StaticOrder S; S.init(M, 2 * FF, G, bx); EpiSwiglu E{HB};
                  pg8::gemm_phase<EpiSwiglu, pg8::StaticOrder, true, true>(lds, g, S, E); } SEAM(10);
    if (IN(11)) { pg8::Gemm g{HB, (const bf16*)(ws + WS_W2B), M, D, FF}; pg8::StaticOrder S; S.init(M, D, G, bx); EpiResid E{R, R, 0.5f};
                  pg8::gemm_phase<EpiResid, pg8::StaticOrder, true, true>(lds, g, S, E); } SEAM(11);
    if (IN(12)) { ln_phase(R, R, nullptr, A.in[27], A.in[28], lane, wave); }
#undef IN
#undef SEAM
}

extern "C" void kernel_launch(void* const* d_in, const int* in_sizes, int n_in, void* d_out, int out_size, void* d_ws, size_t ws_size, hipStream_t stream) {
    static int grid = 0;
    if (grid == 0) {
        if (n_in != 29 || in_sizes[0] != M * D || out_size != M * D || ws_size < WS_END) { fprintf(stderr, "kernel_launch: unexpected problem shape (n_in %d, ws %zu)\n", n_in, ws_size); grid = -1; return; }
        int dev = 0, cus = 0, per_cu = 0;
        (void)hipGetDevice(&dev); (void)hipDeviceGetAttribute(&cus, hipDeviceAttributeMultiprocessorCount, dev);
        if (hipFuncSetAttribute((const void*)mk_fwd, hipFuncAttributeMaxDynamicSharedMemorySize, LDS_BYTES) != hipSuccess) fprintf(stderr, "kernel_launch: hipFuncSetAttribute failed\n");
        if (hipOccupancyMaxActiveBlocksPerMultiprocessor(&per_cu, (const void*)mk_fwd, NTHR, LDS_BYTES) != hipSuccess || per_cu < 1) { fprintf(stderr, "kernel_launch: occupancy query says %d blocks per CU\n", per_cu); per_cu = 1; }
        (void)hipGetLastError();
        grid = cus * per_cu; if (grid > 256) grid = 256; if (grid < 1) grid = 1;
    }
    if (grid < 0) return;
    (void)hipMemsetAsync(d_ws, 0, 65536, stream);
    Args a{};
    for (int i = 0; i < 29; ++i) a.in[i] = (const float*)d_in[i];
    a.out = (float*)d_out; a.ws = (unsigned char*)d_ws;
#if MK_PER_PHASE
    const int order[14] = {0, 1, 2, 3, 4, 5, 6, 13, 7, 8, 9, 10, 11, 12};
    for (int i = 0; i < 14; ++i) { a.ph_lo = order[i]; a.ph_hi = order[i] + 1; hipLaunchKernelGGL(mk_fwd, dim3(grid), dim3(NTHR), LDS_BYTES, stream, a); }
#else
    a.ph_lo = 0; a.ph_hi = NPHASE;
    void* args[] = {&a};
    const hipError_t e = hipLaunchCooperativeKernel((const void*)mk_fwd, dim3(grid), dim3(NTHR), args, LDS_BYTES, stream);
    if (e != hipSuccess) fprintf(stderr, "kernel_launch: cooperative launch failed: %s (grid %d)\n", hipGetErrorString(e), grid);
#endif
}
```

```cpp
#include <hip/hip_runtime.h>
#include <hip/hip_cooperative_groups.h>
#include <cstdio>
#include <cstdint>
namespace cg = cooperative_groups;
namespace pg8 {
#define PG8_LAS __attribute__((address_space(3)))
typedef unsigned short bf16_t;
typedef short bf16x8 __attribute__((ext_vector_type(8)));
typedef float f32x4 __attribute__((ext_vector_type(4)));
typedef unsigned u32x4 __attribute__((ext_vector_type(4)));
constexpr int BM = 256, BK = 64, HALF = 128, HTB = HALF * BK * 2  , STAGE_BYTES = 8 * HTB, NXCD = 8, WGM = 8;

__host__ __device__ __forceinline__ int lds_byte(int r, int c) { const int st = (r >> 4) * 2 + (c >> 5), rr = r & 15, cc = c & 31, ob = rr * 64 + cc * 2; return st * 1024 + (ob ^ (((ob >> 9) & 1) << 5)); }
__host__ __device__ __forceinline__ void stage_rc(int b, int& R, int& C) { const int st = b / 1024, sb = b % 1024, swz = sb ^ (((sb >> 9) & 1) << 5); R = (st >> 1) * 16 + swz / 64; C = (st & 1) * 32 + (swz % 64) / 2; }
__host__ __device__ __forceinline__ int perm32(int rho) { const int n = rho >> 4, i = rho & 15; return 8 * (i >> 2) + 4 * n + (i & 3); }

struct Unit { int pm, pn; };
struct Gemm { const bf16_t* A; const bf16_t* Bt; int M, N, K; };

struct StaticOrder {
    int nM, nN, nwg, G, c;
    __host__ __device__ void init(int M, int N, int G_, int c_) { nM = M / BM; nN = N / BM; nwg = nM * nN; G = G_; c = c_; }
    __host__ __device__ bool next(int i, Unit& u) const {
        const long L = (long)i * G + c; if (L >= nwg) return false;
        int wgid = (int)L; { const int q = nwg / NXCD, r = nwg % NXCD, xcd = wgid % NXCD, off = wgid / NXCD; wgid = (xcd < r ? xcd * (q + 1) : r * (q + 1) + (xcd - r) * q) + off; }
        const int nig = WGM * nN, gid = wgid / nig, fm = gid * WGM, gsz = (nM - fm) < WGM ? (nM - fm) : WGM;
        u.pm = fm + ((wgid % nig) % gsz); u.pn = (wgid % nig) / gsz; return true;
    }
    __device__ __forceinline__ void a_ready(const Unit&) const {}
    __device__ __forceinline__ void done(const Unit&) const {}
};

__device__ __forceinline__ unsigned cvt_pk_bf16(float lo, float hi) { unsigned r; asm volatile("v_cvt_pk_bf16_f32 %0, %1, %2" : "=v"(r) : "v"(lo), "v"(hi)); return r; }
template <class Epi, class Sched, bool ALIGN_EPI = false, bool SP2 = false>
__device__ __forceinline__ void gemm_phase(PG8_LAS unsigned char* lds, const Gemm g, const Sched& S, const Epi& E) {
    const int tid = threadIdx.x, wid = __builtin_amdgcn_readfirstlane(tid >> 6), lane = tid & 63, wr = wid >> 2, wc = wid & 3, fr = lane & 15, fq = lane >> 4;
    const int K = g.K, nt = K / BK;
    unsigned voffA[2], voffB[2];
#pragma unroll
    for (int i = 0; i < 2; ++i) { int R, C; stage_rc(tid * 16 + i * 8192, R, C); const int Rb = Epi::PERM ? ((R & ~31) + perm32(R & 31)) : R;
        voffA[i] = (unsigned)(R * K + C) * 2u; voffB[i] = (unsigned)(Rb * K + C) * 2u; }
    const size_t kstep = (size_t)(BK * 2);
    const size_t hstep = (size_t)HALF * K * 2;
    const size_t tstep = 2 * hstep;
    const unsigned ldsw = (unsigned)wid * 1024u;
    const int aoff = lds_byte(wr * 64 + fr, fq * 8), boff = lds_byte(wc * 32 + fr, fq * 8);
#define PG8_SA(b, h) (((b) * 2 + (h)) * HTB)
#define PG8_SB(b, h) ((4 + (b) * 2 + (h)) * HTB)
#define PG8_STAGE(bufoff, gbase, voff) do { _Pragma("unroll") for (int _i = 0; _i < 2; ++_i) \
        __builtin_amdgcn_global_load_lds((const unsigned*)((const char*)(gbase) + (voff)[_i]), (PG8_LAS unsigned*)(lds + (bufoff) + ldsw + _i * 8192), 16, 0, 0); } while (0)
#define PG8_LDA(dst, b, h) do { _Pragma("unroll") for (int m = 0; m < 4; ++m) _Pragma("unroll") for (int k = 0; k < 2; ++k) dst[m][k] = *(const PG8_LAS bf16x8*)(lds + PG8_SA(b, h) + aoff + m * 2048 + k * 1024); } while (0)
#define PG8_LDB(dst, b, h) do { _Pragma("unroll") for (int n = 0; n < 2; ++n) _Pragma("unroll") for (int k = 0; k < 2; ++k) dst[n][k] = *(const PG8_LAS bf16x8*)(lds + PG8_SB(b, h) + boff + n * 2048 + k * 1024); } while (0)
#define PG8_MMA(ai, bj, At, Bt) do { __builtin_amdgcn_s_setprio(1); _Pragma("unroll") for (int m = 0; m < 4; ++m) _Pragma("unroll") for (int n = 0; n < 2; ++n) _Pragma("unroll") for (int k = 0; k < 2; ++k) \
        acc[ai][bj][m][n] = __builtin_amdgcn_mfma_f32_16x16x32_bf16(Bt[n][k], At[m][k], acc[ai][bj][m][n], 0, 0, 0); __builtin_amdgcn_s_setprio(0); } while (0)
#define PG8_WAIT_V(n) asm volatile("s_waitcnt vmcnt(" #n ")" ::: "memory")
#define PG8_WAIT_L(n) asm volatile("s_waitcnt lgkmcnt(" #n ")" ::: "memory")
#define PG8_BAR __builtin_amdgcn_s_barrier()
#define PG8_SCHED __builtin_amdgcn_sched_barrier(0)
    Unit cur, nxt; int ui = 0;
    if (!S.next(0, cur)) return;
    f32x4 acc[2][2][4][2];
#pragma unroll
    for (int a = 0; a < 2; ++a)
#pragma unroll
        for (int b = 0; b < 2; ++b)
#pragma unroll
            for (int m = 0; m < 4; ++m)
#pragma unroll
                for (int n = 0; n < 2; ++n) acc[a][b][m][n] = (f32x4){0.f, 0.f, 0.f, 0.f};
    bf16x8 At[4][2], B0[2][2], B1[2][2];
    const char* cA = (const char*)g.A + (size_t)cur.pm * tstep; const char* cB = (const char*)g.Bt + (size_t)cur.pn * tstep;
    S.a_ready(cur);
    if constexpr (SP2) {
        PG8_STAGE(PG8_SB(0, 0), cB, voffB); PG8_STAGE(PG8_SB(0, 1), cB + hstep, voffB); PG8_STAGE(PG8_SA(0, 0), cA, voffA); PG8_STAGE(PG8_SA(0, 1), cA + hstep, voffA);
        if (wr == 1) PG8_BAR;
        PG8_WAIT_V(2); PG8_BAR;
        PG8_STAGE(PG8_SB(1, 0), cB + kstep, voffB); PG8_STAGE(PG8_SA(1, 0), cA + kstep, voffA); PG8_STAGE(PG8_SB(1, 1), cB + hstep + kstep, voffB);
        PG8_WAIT_V(6); PG8_BAR;
    } else {
        PG8_STAGE(PG8_SB(0, 0), cB, voffB); PG8_STAGE(PG8_SA(0, 0), cA, voffA); PG8_STAGE(PG8_SB(0, 1), cB + hstep, voffB); PG8_STAGE(PG8_SA(0, 1), cA + hstep, voffA);
        if (wr == 1) PG8_BAR;
        PG8_WAIT_V(4); PG8_BAR;
        PG8_STAGE(PG8_SB(1, 0), cB + kstep, voffB); PG8_STAGE(PG8_SA(1, 0), cA + kstep, voffA); PG8_STAGE(PG8_SB(1, 1), cB + hstep + kstep, voffB);
        PG8_WAIT_V(6); PG8_BAR;
    }
    for (;;) {
        const bool has_next = S.next(ui + 1, nxt);
        const char* nA = has_next ? (const char*)g.A + (size_t)nxt.pm * tstep : cA; const char* nB = has_next ? (const char*)g.Bt + (size_t)nxt.pn * tstep : cB;
        for (int t = 0; t < nt; t += 2) {
            const bool last = (t == nt - 2);
            const char* a1 = cA + (size_t)(t + 1) * kstep;
            const char* a2 = last ? nA : cA + (size_t)(t + 2) * kstep; const char* b2 = last ? nB : cB + (size_t)(t + 2) * kstep;
            const char* a3 = a2 + kstep; const char* b3 = b2 + kstep;
            if (last && has_next) S.a_ready(nxt);
            if constexpr (SP2) {
            PG8_LDB(B0, 0, 0); PG8_LDB(B1, 0, 1); PG8_SCHED; PG8_LDA(At, 0, 0); PG8_STAGE(PG8_SA(1, 1), a1 + hstep, voffA);
            PG8_WAIT_V(8); PG8_WAIT_L(0); PG8_BAR; PG8_MMA(0, 0, At, B0); PG8_MMA(0, 1, At, B1); PG8_BAR; PG8_SCHED;
            PG8_LDA(At, 0, 1); PG8_STAGE(PG8_SB(0, 0), b2, voffB); PG8_STAGE(PG8_SB(0, 1), b2 + hstep, voffB); PG8_STAGE(PG8_SA(0, 0), a2, voffA);
            PG8_WAIT_V(8); PG8_WAIT_L(0); PG8_BAR; PG8_MMA(1, 0, At, B0); PG8_MMA(1, 1, At, B1); PG8_BAR; PG8_SCHED;
            PG8_LDB(B0, 1, 0); PG8_LDB(B1, 1, 1); PG8_SCHED; PG8_LDA(At, 1, 0); PG8_STAGE(PG8_SA(0, 1), a2 + hstep, voffA);
            PG8_WAIT_V(8); PG8_WAIT_L(0); PG8_BAR; PG8_MMA(0, 0, At, B0); PG8_MMA(0, 1, At, B1); PG8_BAR; PG8_SCHED;
            PG8_LDA(At, 1, 1); PG8_STAGE(PG8_SB(1, 0), b3, voffB); PG8_STAGE(PG8_SB(1, 1), b3 + hstep, voffB); PG8_STAGE(PG8_SA(1, 0), a3, voffA);
            PG8_WAIT_V(8); PG8_WAIT_L(0); PG8_BAR; PG8_MMA(1, 0, At, B0); PG8_MMA(1, 1, At, B1); PG8_BAR; PG8_SCHED;
            } else {
            PG8_LDB(B0, 0, 0); PG8_SCHED; PG8_LDA(At, 0, 0); PG8_STAGE(PG8_SA(1, 1), a1 + hstep, voffA);
            PG8_WAIT_L(8); PG8_BAR; PG8_WAIT_L(0); PG8_MMA(0, 0, At, B0); PG8_BAR; PG8_SCHED;
            PG8_LDB(B1, 0, 1); PG8_STAGE(PG8_SB(0, 0), b2, voffB);
            PG8_BAR; PG8_WAIT_L(0); PG8_MMA(0, 1, At, B1); PG8_BAR;
            PG8_LDA(At, 0, 1); PG8_STAGE(PG8_SA(0, 0), a2, voffA);
            PG8_BAR; PG8_WAIT_L(0); PG8_MMA(1, 0, At, B0); PG8_BAR; PG8_SCHED;
            PG8_STAGE(PG8_SB(0, 1), b2 + hstep, voffB);
            PG8_WAIT_V(6); PG8_BAR; PG8_MMA(1, 1, At, B1); PG8_BAR;
            PG8_LDB(B0, 1, 0); PG8_SCHED; PG8_LDA(At, 1, 0); PG8_STAGE(PG8_SA(0, 1), a2 + hstep, voffA);
            PG8_WAIT_L(8); PG8_BAR; PG8_WAIT_L(0); PG8_MMA(0, 0, At, B0); PG8_BAR; PG8_SCHED;
            PG8_LDB(B1, 1, 1); PG8_STAGE(PG8_SB(1, 0), b3, voffB);
            PG8_BAR; PG8_WAIT_L(0); PG8_MMA(0, 1, At, B1); PG8_BAR;
            PG8_LDA(At, 1, 1); PG8_STAGE(PG8_SA(1, 0), a3, voffA);
            PG8_BAR; PG8_WAIT_L(0); PG8_MMA(1, 0, At, B0); PG8_BAR; PG8_SCHED;
            PG8_STAGE(PG8_SB(1, 1), b3 + hstep, voffB);
            PG8_WAIT_V(6); PG8_BAR; PG8_MMA(1, 1, At, B1); PG8_BAR;
            }
        }
        if constexpr (ALIGN_EPI) { if (wr == 0) PG8_BAR; }
        if constexpr (!Epi::AFTER_DRAIN) { E(acc, cur, wr, wc, fr, fq); S.done(cur); }
        if (!has_next) break;
#pragma unroll
        for (int a = 0; a < 2; ++a)
#pragma unroll
            for (int b = 0; b < 2; ++b)
#pragma unroll
                for (int m = 0; m < 4; ++m)
#pragma unroll
                    for (int n = 0; n < 2; ++n) acc[a][b][m][n] = (f32x4){0.f, 0.f, 0.f, 0.f};
        cur = nxt; cA = nA; cB = nB; ++ui;
        if constexpr (ALIGN_EPI) { if (wr == 1) PG8_BAR; }
    }
    PG8_WAIT_V(0);
    if constexpr (!ALIGN_EPI) { if (wr == 0) PG8_BAR; }
    PG8_BAR;
    if constexpr (Epi::AFTER_DRAIN) { E.fused(acc, cur, wr, wc, fr, fq, lds, wid, lane); S.done(cur); }
#undef PG8_SA
#undef PG8_SB
#undef PG8_STAGE
#undef PG8_LDA
#undef PG8_LDB
#undef PG8_MMA
#undef PG8_WAIT_V
#undef PG8_WAIT_L
#undef PG8_BAR
#undef PG8_SCHED
}
}
#ifndef MK_PER_PHASE
#define MK_PER_PHASE 0
#endif
#define LAS __attribute__((address_space(3)))
typedef unsigned short bf16;
typedef _Float16 f16;
typedef float f32x4 __attribute__((ext_vector_type(4)));
typedef float f32x2 __attribute__((ext_vector_type(2)));
typedef short bf16x8 __attribute__((ext_vector_type(8)));
typedef unsigned u32x4 __attribute__((ext_vector_type(4)));
typedef unsigned u32x2 __attribute__((ext_vector_type(2)));
typedef _Float16 f16x8 __attribute__((ext_vector_type(8)));

constexpr int M = 16384, D = 1024, FF = 2816, SEQ = 8192, NFFT = 16384;
constexpr float ALPHA = 1.1892071150027210667f;
constexpr float LN_EPS = 1e-5f;
constexpr int NTHR = 512, NWAVES = 8;
constexpr int LDS_BYTES = 147456;
constexpr int NPHASE = 13;

constexpr size_t MiB = 1u << 20;
constexpr size_t WS_RPB = 65536;
constexpr size_t WS_PART = 1 * MiB;
constexpr size_t WS_W13A = 8 * MiB, WS_W2A = 19 * MiB, WS_WIN = 25 * MiB, WS_WPA = 35 * MiB, WS_WPB = 36 * MiB, WS_WOUT = 37 * MiB, WS_W13B = 39 * MiB, WS_W2B = 50 * MiB;
constexpr size_t WS_XB = 56 * MiB;
constexpr size_t WS_H = 88 * MiB;
constexpr size_t WS_Q = 88 * MiB, WS_K = 104 * MiB, WS_VT = 120 * MiB, WS_KC = 136 * MiB;
constexpr size_t WS_GATE = 104 * MiB;
constexpr size_t WS_UT = 176 * MiB;
constexpr size_t WS_YB = 192 * MiB;
constexpr size_t WS_KT = 224 * MiB;
constexpr size_t WS_MIX = 224 * MiB;
constexpr size_t WS_END = 256 * MiB;

struct Args { const float* in[29]; float* out; unsigned char* ws; int ph_lo, ph_hi; };

typedef __bf16 bf16x2_t __attribute__((ext_vector_type(2)));
__device__ __forceinline__ unsigned pkbf(float lo, float hi) { const f32x2 v = {lo, hi}; const bf16x2_t b = __builtin_convertvector(v, bf16x2_t); return __builtin_bit_cast(unsigned, b); }
__device__ __forceinline__ float bf2f(unsigned short b) { return __uint_as_float(((unsigned)b) << 16); }
__device__ __forceinline__ int opaque(int v) { asm volatile("" : "+v"(v)); return v; }
__device__ __forceinline__ float wave_sum(float v) {
#pragma unroll
    for (int o = 1; o < 64; o <<= 1) v += __shfl_xor(v, o);
    return v;
}

using pg8::Unit;
struct EpiSwiglu {
    static constexpr bool PERM = true, AFTER_DRAIN = false;
    bf16* H;
    __device__ __forceinline__ void operator()(const f32x4 (&acc)[2][2][4][2], const Unit& u, int wr, int wc, int fr, int fq) const {
        const int row0 = u.pm * 256 + wr * 64 + fr, col0 = u.pn * 128 + wc * 32 + 8 * fq;
#pragma unroll
        for (int ai = 0; ai < 2; ++ai)
#pragma unroll
            for (int m = 0; m < 4; ++m) {
                float o[8];
#pragma unroll
                for (int n = 0; n < 2; ++n)
#pragma unroll
                    for (int e = 0; e < 4; ++e) { const float a = acc[ai][0][m][n][e], b = acc[ai][1][m][n][e];
                        const float sg = __builtin_amdgcn_rcpf(1.0f + __builtin_amdgcn_exp2f(-1.4426950408889634f * a)); o[n * 4 + e] = a * sg * b; }
                u32x4 w; w.x = pkbf(o[0], o[1]); w.y = pkbf(o[2], o[3]); w.z = pkbf(o[4], o[5]); w.w = pkbf(o[6], o[7]);
                *(u32x4*)(H + (size_t)(row0 + ai * 128 + m * 16) * FF + col0) = w;
            }
    }
};
struct EpiResid {
    static constexpr bool PERM = false, AFTER_DRAIN = false;
    const float* resid; float* out; float s;
    __device__ __forceinline__ void operator()(const f32x4 (&acc)[2][2][4][2], const Unit& u, int wr, int wc, int fr, int fq) const {
        const int row0 = u.pm * 256 + wr * 64 + fr, col0 = u.pn * 256 + wc * 32 + 4 * fq;
#pragma unroll
        for (int ai = 0; ai < 2; ++ai)
#pragma unroll
            for (int m = 0; m < 4; ++m) { const size_t off = (size_t)(row0 + ai * 128 + m * 16) * D + col0;
#pragma unroll
                for (int bj = 0; bj < 2; ++bj)
#pragma unroll
                    for (int n = 0; n < 2; ++n) { const f32x4 rv = *(const f32x4*)(resid + off + bj * 128 + n * 16);
                        *(f32x4*)(out + off + bj * 128 + n * 16) = rv * ALPHA + acc[ai][bj][m][n] * s; } }
    }
};
struct EpiIn {
    static constexpr bool PERM = true, AFTER_DRAIN = false;
    bf16* Q; bf16* Kb; bf16* Vt; f16* uT;
    __device__ __forceinline__ void operator()(const f32x4 (&acc)[2][2][4][2], const Unit& u, int wr, int wc, int fr, int fq) const {
        const int row0 = u.pm * 256 + wr * 64 + fr;
        if (u.pn < 4) {
            bf16* base = (u.pn < 2) ? Q : Kb; const float sc = (u.pn < 2) ? 0.125f : 1.0f; const int col0 = (u.pn & 1) * 256 + wc * 32 + 8 * fq;
#pragma unroll
            for (int ai = 0; ai < 2; ++ai)
#pragma unroll
                for (int m = 0; m < 4; ++m)
#pragma unroll
                    for (int bj = 0; bj < 2; ++bj) { const f32x4 v0 = acc[ai][bj][m][0] * sc, v1 = acc[ai][bj][m][1] * sc;
                        u32x4 w; w.x = pkbf(v0[0], v0[1]); w.y = pkbf(v0[2], v0[3]); w.z = pkbf(v1[0], v1[1]); w.w = pkbf(v1[2], v1[3]);
                        *(u32x4*)(base + (size_t)(row0 + ai * 128 + m * 16) * 512 + col0 + bj * 128) = w; }
        } else if (u.pn < 6) {
            const int b = row0 >> 13, t0 = row0 & 8191, vc0 = (u.pn - 4) * 256 + wc * 32 + 8 * fq;
#pragma unroll
            for (int ai = 0; ai < 2; ++ai)
#pragma unroll
                for (int m = 0; m < 4; ++m)
#pragma unroll
                    for (int bj = 0; bj < 2; ++bj)
#pragma unroll
                        for (int n = 0; n < 2; ++n)
#pragma unroll
                            for (int e = 0; e < 4; ++e)
                                Vt[(((size_t)(b * 512 + vc0 + bj * 128 + n * 4 + e)) << 13) + t0 + ai * 128 + m * 16] = (bf16)(pkbf(acc[ai][bj][m][n][e], 0.f) & 0xffffu);
        } else {
            const int uc0 = (u.pn - 6) * 256 + wc * 32 + 8 * fq;
#pragma unroll
            for (int ai = 0; ai < 2; ++ai)
#pragma unroll
                for (int m = 0; m < 4; ++m)
#pragma unroll
                    for (int bj = 0; bj < 2; ++bj)
#pragma unroll
                        for (int n = 0; n < 2; ++n)
#pragma unroll
                            for (int e = 0; e < 4; ++e)
                                uT[(size_t)(uc0 + bj * 128 + n * 4 + e) * M + row0 + ai * 128 + m * 16] = (f16)acc[ai][bj][m][n][e];
        }
    }
};
struct EpiGate {
    static constexpr bool PERM = true, AFTER_DRAIN = false;
    bf16* G; const float* bg;
    __device__ __forceinline__ void operator()(const f32x4 (&acc)[2][2][4][2], const Unit& u, int wr, int wc, int fr, int fq) const {
        const int row0 = u.pm * 256 + wr * 64 + fr, col0 = u.pn * 256 + wc * 32 + 8 * fq;
#pragma unroll
        for (int bj = 0; bj < 2; ++bj) { const f32x4 b0 = *(const f32x4*)(bg + col0 + bj * 128), b1 = *(const f32x4*)(bg + col0 + bj * 128 + 4);
#pragma unroll
            for (int ai = 0; ai < 2; ++ai)
#pragma unroll
                for (int m = 0; m < 4; ++m) { float o[8];
#pragma unroll
                    for (int e = 0; e < 4; ++e) { o[e] = __builtin_amdgcn_rcpf(1.0f + __builtin_amdgcn_exp2f(-1.4426950408889634f * (acc[ai][bj][m][0][e] + b0[e])));
                                                  o[4 + e] = __builtin_amdgcn_rcpf(1.0f + __builtin_amdgcn_exp2f(-1.4426950408889634f * (acc[ai][bj][m][1][e] + b1[e]))); }
                    u32x4 w; w.x = pkbf(o[0], o[1]); w.y = pkbf(o[2], o[3]); w.z = pkbf(o[4], o[5]); w.w = pkbf(o[6], o[7]);
                    *(u32x4*)(G + (size_t)(row0 + ai * 128 + m * 16) * 2048 + col0 + bj * 128) = w; } }
    }
};
template <int SECOND> struct EpiMix {
    static constexpr bool PERM = true, AFTER_DRAIN = false;
    bf16* X; const bf16* G;
    __device__ __forceinline__ void operator()(const f32x4 (&acc)[2][2][4][2], const Unit& u, int wr, int wc, int fr, int fq) const {
        const int row0 = u.pm * 256 + wr * 64 + fr, col0 = u.pn * 256 + wc * 32 + 8 * fq;
#pragma unroll
        for (int ai = 0; ai < 2; ++ai)
#pragma unroll
            for (int m = 0; m < 4; ++m)
#pragma unroll
                for (int bj = 0; bj < 2; ++bj) { const size_t r = (size_t)(row0 + ai * 128 + m * 16);
                    const u32x4 g = *(const u32x4*)(G + r * 2048 + SECOND * 1024 + col0 + bj * 128);
                    u32x4 p = {0u, 0u, 0u, 0u}; if (SECOND) p = *(const u32x4*)(X + r * D + col0 + bj * 128);
                    float o[8];
#pragma unroll
                    for (int j = 0; j < 4; ++j) { const unsigned gw = g[j], pw = p[j]; const float a0 = acc[ai][bj][m][j >> 1][(j & 1) * 2], a1 = acc[ai][bj][m][j >> 1][(j & 1) * 2 + 1];
                        o[2 * j] = __uint_as_float(gw << 16) * a0 + __uint_as_float(pw << 16); o[2 * j + 1] = __uint_as_float(gw & 0xffff0000u) * a1 + __uint_as_float(pw & 0xffff0000u); }
                    u32x4 w; w.x = pkbf(o[0], o[1]); w.y = pkbf(o[2], o[3]); w.z = pkbf(o[4], o[5]); w.w = pkbf(o[6], o[7]);
                    *(u32x4*)(X + r * D + col0 + bj * 128) = w; }
    }
};
__device__ __forceinline__ void p0_transpose_item(const float* W, int K, int N, bf16* WT, int mode, int row_off, LAS float* scr, int item, int lane) {
    const int nblk = N / 32, kb = item / nblk, nb = item % nblk, k0 = 64 * kb, n0 = 32 * nb;
    float wv[32];
#pragma unroll
    for (int i = 0; i < 32; ++i) wv[i] = W[(size_t)(k0 + 2 * i + (lane >> 5)) * N + n0 + (lane & 31)];
#pragma unroll
    for (int i = 0; i < 32; ++i) scr[(2 * i + (lane >> 5)) * 33 + (lane & 31)] = wv[i];
    asm volatile("s_waitcnt lgkmcnt(0)" ::: "memory");
    const int drow0 = mode ? ((n0 >> 7) * 256 + (n0 & 127) + row_off) : (row_off + n0);
    const int c = lane & 7;
#pragma unroll
    for (int j = 0; j < 4; ++j) { const int n = (lane >> 3) + 8 * j; const LAS float* s = scr + (8 * c) * 33 + n;
        u32x4 o; o.x = pkbf(s[0 * 33], s[1 * 33]); o.y = pkbf(s[2 * 33], s[3 * 33]); o.z = pkbf(s[4 * 33], s[5 * 33]); o.w = pkbf(s[6 * 33], s[7 * 33]);
        *(u32x4*)(WT + (size_t)(drow0 + n) * K + k0 + 8 * c) = o; }
    asm volatile("s_waitcnt lgkmcnt(0)" ::: "memory");
}

__device__ __forceinline__ void filter_tile(const Args& A, LAS unsigned char* lds, int tile, int tid) {
    const float* fw1 = A.in[11]; const float* fb1 = A.in[12]; const float* fw2 = A.in[13]; const float* fb2 = A.in[14];
    const float* fw3 = A.in[15]; const float* fb3 = A.in[16]; const float* freq = A.in[17];
    LAS float* zf = (LAS float*)lds;
    LAS float* h1 = zf + 33 * 33 + 3;
    LAS float* h2 = h1 + 33 * 64;
    const int t0 = tile * 32;
#pragma unroll 1
    for (int idx = tid; idx < 33 * 16; idx += NTHR) { const int tt = idx >> 4, f = idx & 15, i = t0 + tt;
        const float fj = 1e-4f + (float)f * ((15.0f - 1e-4f) / 15.0f), w = (6.283185307179586f / 8192.0f) * (float)i;
        const float s = __sinf(fj * w), c = __cosf(fj * w);
        zf[tt * 33 + 1 + f] = c; zf[tt * 33 + 17 + f] = -s; if (f == 0) zf[tt * 33] = (float)i * (1.0f / 8191.0f); }
    __syncthreads();
#pragma unroll 1
    for (int idx = tid; idx < 33 * 64; idx += NTHR) { const int tt = idx >> 6, o = idx & 63; float a = fb1[o];
#pragma unroll 1
        for (int f = 0; f < 33; ++f) a += zf[tt * 33 + f] * fw1[f * 64 + o];
        h1[tt * 64 + o] = __sinf(freq[o] * a); }
    __syncthreads();
#pragma unroll 1
    for (int idx = tid; idx < 33 * 64; idx += NTHR) { const int tt = idx >> 6, o = idx & 63; float a = fb2[o];
#pragma unroll 4
        for (int j = 0; j < 64; ++j) a += h1[tt * 64 + j] * fw2[j * 64 + o];
        h2[tt * 64 + o] = __sinf(freq[o] * a); }
    __syncthreads();
    const float dmin = 3.0701134573253945f, dmax = 15.350567286626973f;
    LAS f16* tl = (LAS f16*)(lds + 24576);
    float* part = (float*)(A.ws + WS_PART);
    f16* kT = (f16*)(A.ws + WS_KT);
#pragma unroll 1
    for (int dir = 0; dir < 2; ++dir) {
        const int col0 = dir * 1024 + tid * 2, c0 = col0 & 511;
        float acc[32][2];
#pragma unroll
        for (int tt = 0; tt < 32; ++tt) { acc[tt][0] = 0.f; acc[tt][1] = 0.f; }
        const LAS float* h2d = h2 + dir * 64;
#pragma unroll 1
        for (int j = 0; j < 64; j += 4) {
            const f32x2 w0 = *(const f32x2*)(fw3 + (size_t)(j + 0) * 2048 + col0), w1 = *(const f32x2*)(fw3 + (size_t)(j + 1) * 2048 + col0),
                        w2 = *(const f32x2*)(fw3 + (size_t)(j + 2) * 2048 + col0), w3 = *(const f32x2*)(fw3 + (size_t)(j + 3) * 2048 + col0);
#pragma unroll
            for (int tt = 0; tt < 32; ++tt) { const f32x4 hv = *(const LAS f32x4*)(h2d + tt * 64 + j);
#pragma unroll
                for (int c = 0; c < 2; ++c) acc[tt][c] += hv[0] * w0[c] + hv[1] * w1[c] + hv[2] * w2[c] + hv[3] * w3[c]; }
        }
        const f32x2 b3 = *(const f32x2*)(fb3 + col0);
        const float d0 = dmin + (float)(c0) * ((dmax - dmin) / 511.0f), d1 = dmin + (float)(c0 + 1) * ((dmax - dmin) / 511.0f);
        float ss0 = 0.f, ss1 = 0.f;
#pragma unroll
        for (int tt = 0; tt < 32; ++tt) { const int i = t0 + tt + dir; const float tl_ = (float)i * (1.0f / 8191.0f);
            float v0 = (acc[tt][0] + b3[0]) * __expf(-tl_ * d0), v1 = (acc[tt][1] + b3[1]) * __expf(-tl_ * d1); if (i >= 8192) { v0 = 0.f; v1 = 0.f; }
            ss0 += v0 * v0; ss1 += v1 * v1;
            tl[(tid * 2) * 34 + tt] = (f16)v0; tl[(tid * 2 + 1) * 34 + tt] = (f16)v1; }
        *(f32x2*)(part + (size_t)tile * 2048 + col0) = (f32x2){ss0, ss1};
        __syncthreads();
#pragma unroll 1
        for (int it = 0; it < 8; ++it) { const int chunk = it * NTHR + opaque(tid), row = chunk >> 2, p = chunk & 3;
            f16x8 o;
            if (dir == 0) {
#pragma unroll
                for (int e = 0; e < 8; ++e) o[e] = tl[row * 34 + p * 8 + e];
                *(f16x8*)(kT + (size_t)row * NFFT + t0 + p * 8) = o;
            } else {
#pragma unroll
                for (int e = 0; e < 8; ++e) o[e] = tl[row * 34 + 31 - p * 8 - e];
                *(f16x8*)(kT + (size_t)row * NFFT + (NFFT - t0 - 32) + p * 8) = o;
            }
        }
        __syncthreads();
    }
}

__device__ __forceinline__ void p0_prologue(const Args& A, LAS unsigned char* lds, int tid, int lane, int wave) {
    unsigned char* ws = A.ws;
    LAS float* scr = (LAS float*)(lds + wave * 16384);
    const int gw = blockIdx.x * NWAVES + wave, NGW = gridDim.x * NWAVES;
    constexpr int I_UP = (D / 64) * (FF / 32), I_DN = (FF / 64) * (D / 32), I_IN = (D / 64) * (5120 / 32), I_P = (512 / 64) * (D / 32), I_O = (D / 64) * (D / 32);
    constexpr int NITEMS = 6 * I_UP   + I_IN + 2 * I_P + I_O;
    static_assert(I_UP == I_DN, "item counts");
    for (int it = gw; it < NITEMS; it += NGW) {
        int r = it;
        if (r < I_UP) { p0_transpose_item(A.in[3], D, FF, (bf16*)(ws + WS_W13A), 1, 0, scr, r, lane); continue; } r -= I_UP;
        if (r < I_UP) { p0_transpose_item(A.in[4], D, FF, (bf16*)(ws + WS_W13A), 1, 128, scr, r, lane); continue; } r -= I_UP;
        if (r < I_DN) { p0_transpose_item(A.in[5], FF, D, (bf16*)(ws + WS_W2A), 0, 0, scr, r, lane); continue; } r -= I_DN;
        if (r < I_IN) { p0_transpose_item(A.in[6], D, 5120, (bf16*)(ws + WS_WIN), 0, 0, scr, r, lane); continue; } r -= I_IN;
        if (r < I_P) { p0_transpose_item(A.in[19], 512, D, (bf16*)(ws + WS_WPA), 0, 0, scr, r, lane); continue; } r -= I_P;
        if (r < I_P) { p0_transpose_item(A.in[20], 512, D, (bf16*)(ws + WS_WPB), 0, 0, scr, r, lane); continue; } r -= I_P;
        if (r < I_O) { p0_transpose_item(A.in[21], D, D, (bf16*)(ws + WS_WOUT), 0, 0, scr, r, lane); continue; } r -= I_O;
        if (r < I_UP) { p0_transpose_item(A.in[24], D, FF, (bf16*)(ws + WS_W13B), 1, 0, scr, r, lane); continue; } r -= I_UP;
        if (r < I_UP) { p0_transpose_item(A.in[25], D, FF, (bf16*)(ws + WS_W13B), 1, 128, scr, r, lane); continue; } r -= I_UP;
        p0_transpose_item(A.in[26], FF, D, (bf16*)(ws + WS_W2B), 0, 0, scr, r, lane);
    }
    if (blockIdx.x == 0) { float* rp = (float*)(ws + WS_RPB); for (int i = tid; i < 8 * 15 * 48; i += NTHR) { const int col = i % 48 - 8; rp[i] = (col >= 0 && col < 31) ? A.in[8][(i / 48) * 31 + col] : 0.f; } }
    { const f32x4* x4 = (const f32x4*)A.in[0]; u32x4* o4 = (u32x4*)(ws + WS_XB);
      const size_t nth = (size_t)gridDim.x * NTHR, n8 = (size_t)M * D / 8;
      for (size_t i = (size_t)blockIdx.x * NTHR + tid; i < n8; i += 4 * nth) { f32x4 a[4], b[4];
#pragma unroll
          for (int j = 0; j < 4; ++j) { a[j] = x4[2 * (i + j * nth)]; b[j] = x4[2 * (i + j * nth) + 1]; }
#pragma unroll
          for (int j = 0; j < 4; ++j) { u32x4 w; w.x = pkbf(a[j][0], a[j][1]); w.y = pkbf(a[j][2], a[j][3]); w.z = pkbf(b[j][0], b[j][1]); w.w = pkbf(b[j][2], b[j][3]); o4[i + j * nth] = w; } } }
    __syncthreads();
    for (int tile = blockIdx.x; tile < 256; tile += gridDim.x) filter_tile(A, lds, tile, tid);
}

__device__ __forceinline__ void ln_phase(const float* src, float* dst, bf16* xb, const float* g, const float* b, int lane, int wave) {
    const int gw = blockIdx.x * NWAVES + wave, NGW = gridDim.x * NWAVES;
    f32x4 gv[4], bv[4];
#pragma unroll
    for (int j = 0; j < 4; ++j) { gv[j] = ((const f32x4*)g)[lane + 64 * j]; bv[j] = ((const f32x4*)b)[lane + 64 * j]; }
    for (int m = gw; m < M; m += NGW) {
        const f32x4* xr = (const f32x4*)(src + (size_t)m * D) + lane;
        f32x4 v[4]; float s = 0.f;
#pragma unroll
        for (int j = 0; j < 4; ++j) { v[j] = xr[64 * j]; s += (v[j][0] + v[j][1]) + (v[j][2] + v[j][3]); }
        const float mean = wave_sum(s) * (1.f / D); float s2 = 0.f;
#pragma unroll
        for (int j = 0; j < 4; ++j) { v[j] = v[j] - mean; s2 += (v[j][0] * v[j][0] + v[j][1] * v[j][1]) + (v[j][2] * v[j][2] + v[j][3] * v[j][3]); }
        const float rstd = 1.0f / sqrtf(wave_sum(s2) * (1.f / D) + LN_EPS);
        f32x4* orow = (f32x4*)(dst + (size_t)m * D) + lane;
#pragma unroll
        for (int j = 0; j < 4; ++j) { const f32x4 o = v[j] * rstd * gv[j] + bv[j]; orow[64 * j] = o;
            if (xb) { u32x2 w; w.x = pkbf(o[0], o[1]); w.y = pkbf(o[2], o[3]); ((u32x2*)(xb + (size_t)m * D))[lane + 64 * j] = w; } }
    }
}
typedef f32x2 cplx;
__device__ __forceinline__ cplx cmul(cplx a, cplx b) { return (cplx){a[0] * b[0] - a[1] * b[1], a[0] * b[1] + a[1] * b[0]}; }
__device__ __forceinline__ cplx cmulc(cplx a, cplx b) { return (cplx){a[0] * b[0] + a[1] * b[1], a[1] * b[0] - a[0] * b[1]}; }
__device__ __forceinline__ int swz(int i) { return i ^ ((i >> 5) & 3) ^ (((i >> 6) & 7) << 2); }
__device__ __forceinline__ cplx twd(const LAS cplx* T1, const LAS cplx* T2, int e) { return cmul(T1[e >> 7], T2[e & 127]); }
__device__ __forceinline__ void bfly_f(cplx& a0, cplx& a1, cplx& a2, cplx& a3) {
    const cplx t0 = a0 + a2, t1 = a0 - a2, t2 = a1 + a3, d = a1 - a3; const cplx t3 = (cplx){d[1], -d[0]};
    a0 = t0 + t2; a1 = t1 + t3; a2 = t0 - t2; a3 = t1 - t3;
}
__device__ __forceinline__ void bfly_i(cplx& a0, cplx& a1, cplx& a2, cplx& a3) {
    const cplx t0 = a0 + a2, t1 = a0 - a2, t2 = a1 + a3, d = a1 - a3; const cplx t3 = (cplx){-d[1], d[0]};
    a0 = t0 + t2; a1 = t1 + t3; a2 = t0 - t2; a3 = t1 - t3;
}
template <int LQ> __device__ __forceinline__ void fwd16(cplx (&r)[16], int j0, const LAS cplx* T1, const LAS cplx* T2) {
    constexpr int SA = 10 - LQ;
#pragma unroll
    for (int c = 0; c < 4; ++c) {
        bfly_f(r[c], r[c + 4], r[c + 8], r[c + 12]);
        const cplx w1 = twd(T1, T2, (j0 + (c << LQ)) << SA), w2 = cmul(w1, w1), w3 = cmul(w1, w2);
        r[c + 4] = cmul(r[c + 4], w1); r[c + 8] = cmul(r[c + 8], w2); r[c + 12] = cmul(r[c + 12], w3);
    }
    const cplx v1 = twd(T1, T2, j0 << (SA + 2)), v2 = cmul(v1, v1), v3 = cmul(v1, v2);
#pragma unroll
    for (int m = 0; m < 4; ++m) {
        bfly_f(r[4 * m], r[4 * m + 1], r[4 * m + 2], r[4 * m + 3]);
        r[4 * m + 1] = cmul(r[4 * m + 1], v1); r[4 * m + 2] = cmul(r[4 * m + 2], v2); r[4 * m + 3] = cmul(r[4 * m + 3], v3);
    }
}
template <int LQ> __device__ __forceinline__ void inv16(cplx (&r)[16], int j0, const LAS cplx* T1, const LAS cplx* T2) {
    constexpr int SA = 10 - LQ;
    const cplx v1 = twd(T1, T2, j0 << (SA + 2)), v2 = cmul(v1, v1), v3 = cmul(v1, v2);
#pragma unroll
    for (int m = 0; m < 4; ++m) {
        r[4 * m + 1] = cmulc(r[4 * m + 1], v1); r[4 * m + 2] = cmulc(r[4 * m + 2], v2); r[4 * m + 3] = cmulc(r[4 * m + 3], v3);
        bfly_i(r[4 * m], r[4 * m + 1], r[4 * m + 2], r[4 * m + 3]);
    }
#pragma unroll
    for (int c = 0; c < 4; ++c) {
        const cplx w1 = twd(T1, T2, (j0 + (c << LQ)) << SA), w2 = cmul(w1, w1), w3 = cmul(w1, w2);
        r[c + 4] = cmulc(r[c + 4], w1); r[c + 8] = cmulc(r[c + 8], w2); r[c + 12] = cmulc(r[c + 12], w3);
        bfly_i(r[c], r[c + 4], r[c + 8], r[c + 12]);
    }
}
template <int LQ, bool INV> __device__ __forceinline__ void lds_pass16(LAS cplx* Z, const LAS cplx* T1, const LAS cplx* T2, int tid) {
#pragma unroll 1
    for (int h = 0; h < 2; ++h) { const int s = opaque(tid) + h * NTHR, j0 = s & ((1 << LQ) - 1), g = (s >> LQ) << (LQ + 4);
        cplx r[16];
#pragma unroll
        for (int k = 0; k < 16; ++k) r[k] = Z[swz(g + j0 + (k << LQ))];
        if (INV) inv16<LQ>(r, j0, T1, T2); else fwd16<LQ>(r, j0, T1, T2);
#pragma unroll
        for (int k = 0; k < 16; ++k) Z[swz(g + j0 + (k << LQ))] = r[k];
    }
}
__device__ __forceinline__ float block_sum(float v, LAS float* red, int tid) {
    v = wave_sum(v); __syncthreads(); if ((tid & 63) == 0) red[tid >> 6] = v; __syncthreads();
    float s = 0.f;
#pragma unroll
    for (int i = 0; i < NWAVES; ++i) s += red[i];
    return s;
}
__device__ __forceinline__ float short_conv(const f16* uT, const float* sw, const float* sb, int ch, int b, int t) {
    const f16* p = uT + (size_t)ch * M + b * SEQ + t;
    const float um = t > 0 ? (float)p[-1] : 0.f, u0 = (float)p[0], up = t < SEQ - 1 ? (float)p[1] : 0.f;
    return sb[ch] + sw[ch] * um + sw[1536 + ch] * u0 + sw[3072 + ch] * up;
}

__device__ __forceinline__ void hyena_channel(const Args& A, LAS unsigned char* lds, int c, int tid) {
    LAS cplx* Z = (LAS cplx*)lds; const LAS cplx* T1 = (const LAS cplx*)(lds + 131072); const LAS cplx* T2 = T1 + 128; LAS float* red = (LAS float*)(lds + 131072 + 2048);
    f16* uT = (f16*)(A.ws + WS_UT); const f16* kT = (const f16*)(A.ws + WS_KT); const float* part = (const float*)(A.ws + WS_PART);
    const float* sw = A.in[9]; const float* sb = A.in[10]; const float* hb = A.in[18];
    unsigned long long* KC = (unsigned long long*)(A.ws + WS_KC) + (size_t)blockIdx.x * NFFT;
    float zr[2][8][2];
    { const float v_b = sb[c], v_w0 = sw[c], v_w1 = sw[1536 + c], v_w2 = sw[3072 + c];
#pragma unroll
    for (int h = 0; h < 2; ++h)
#pragma unroll
        for (int k = 0; k < 8; ++k) {
#pragma unroll
            for (int b = 0; b < 2; ++b) { const int t = tid + h * NTHR + 1024 * k; const f16* p = uT + (size_t)c * M + b * SEQ + t;
                const float um = t > 0 ? (float)p[-1] : 0.f, u0 = (float)p[0], up = t < SEQ - 1 ? (float)p[1] : 0.f;
                zr[h][k][b] = v_b + v_w0 * um + v_w1 * u0 + v_w2 * up; }
            if ((k & 1) == 1) __builtin_amdgcn_sched_barrier(0); } }
#pragma unroll 1
    for (int n = 0; n < 2; ++n) {
        const float ssq = block_sum(part[(size_t)(tid >> 1) * 2048 + (tid & 1) * 1024 + n * 512 + c], red, tid);
        const float kscale = 1.0f / sqrtf(ssq + 1e-12f);
        const f16* kr = kT + (size_t)(n * 512 + c) * NFFT;
#ifndef SK1
#pragma unroll 1
        for (int h = 0; h < 2; ++h) { const int j0 = opaque(tid) + h * NTHR; cplx r[16];
#pragma unroll
            for (int k = 0; k < 16; ++k) r[k] = (cplx){(float)kr[j0 + 1024 * k] * kscale, 0.f};
            fwd16<10>(r, j0, T1, T2);
#pragma unroll
            for (int k = 0; k < 16; ++k) Z[swz(j0 + 1024 * k)] = r[k]; }
#endif
        __syncthreads();
#ifndef SK2
        lds_pass16<6, false>(Z, T1, T2, tid); __syncthreads();
        lds_pass16<2, false>(Z, T1, T2, tid); __syncthreads();
#endif
#pragma unroll 1
        for (int it = 0; it < 8; ++it) { const int bf = it * NTHR + opaque(tid);
            cplx a0 = Z[swz(4 * bf)], a1 = Z[swz(4 * bf + 1)], a2 = Z[swz(4 * bf + 2)], a3 = Z[swz(4 * bf + 3)];
            bfly_f(a0, a1, a2, a3);
            f32x4* o = (f32x4*)(KC + 4 * bf); o[0] = (f32x4){a0[0], a0[1], a1[0], a1[1]}; o[1] = (f32x4){a2[0], a2[1], a3[0], a3[1]}; }
        asm volatile("s_waitcnt vmcnt(0)" ::: "memory");
        __syncthreads();
#pragma unroll 1
        for (int h = 0; h < 2; ++h) { const int j0 = opaque(tid) + h * NTHR; cplx r[16];
#pragma unroll
            for (int k = 0; k < 8; ++k) { r[k] = h ? (cplx){zr[1][k][0], zr[1][k][1]} : (cplx){zr[0][k][0], zr[0][k][1]}; r[k + 8] = (cplx){0.f, 0.f}; }
            fwd16<10>(r, j0, T1, T2);
#pragma unroll
            for (int k = 0; k < 16; ++k) Z[swz(j0 + 1024 * k)] = r[k];
            __builtin_amdgcn_sched_barrier(0); }
        __syncthreads();
        lds_pass16<6, false>(Z, T1, T2, tid); __syncthreads();
        lds_pass16<2, false>(Z, T1, T2, tid); __syncthreads();
#pragma unroll 1
        for (int it = 0; it < 8; ++it) { const int bf = it * NTHR + opaque(tid);
            cplx a0 = Z[swz(4 * bf)], a1 = Z[swz(4 * bf + 1)], a2 = Z[swz(4 * bf + 2)], a3 = Z[swz(4 * bf + 3)];
            bfly_f(a0, a1, a2, a3);
            unsigned long long k0 = __hip_atomic_load(KC + 4 * bf, __ATOMIC_RELAXED, __HIP_MEMORY_SCOPE_AGENT), k1 = __hip_atomic_load(KC + 4 * bf + 1, __ATOMIC_RELAXED, __HIP_MEMORY_SCOPE_AGENT),
                               k2 = __hip_atomic_load(KC + 4 * bf + 2, __ATOMIC_RELAXED, __HIP_MEMORY_SCOPE_AGENT), k3 = __hip_atomic_load(KC + 4 * bf + 3, __ATOMIC_RELAXED, __HIP_MEMORY_SCOPE_AGENT);
            a0 = cmul(a0, (cplx){__uint_as_float((unsigned)k0), __uint_as_float((unsigned)(k0 >> 32))});
            a1 = cmul(a1, (cplx){__uint_as_float((unsigned)k1), __uint_as_float((unsigned)(k1 >> 32))});
            a2 = cmul(a2, (cplx){__uint_as_float((unsigned)k2), __uint_as_float((unsigned)(k2 >> 32))});
            a3 = cmul(a3, (cplx){__uint_as_float((unsigned)k3), __uint_as_float((unsigned)(k3 >> 32))});
            bfly_i(a0, a1, a2, a3);
            Z[swz(4 * bf)] = a0; Z[swz(4 * bf + 1)] = a1; Z[swz(4 * bf + 2)] = a2; Z[swz(4 * bf + 3)] = a3; }
        __syncthreads();
        lds_pass16<2, true>(Z, T1, T2, tid); __syncthreads();
        lds_pass16<6, true>(Z, T1, T2, tid); __syncthreads();
        const float bias = hb[n * 512 + c];
        const int gch = (n + 1) * 512 + c;
        const float g_b = sb[gch], g_w0 = sw[gch], g_w1 = sw[1536 + gch], g_w2 = sw[3072 + gch];
#pragma unroll 1
        for (int h = 0; h < 2; ++h) { const int j0 = opaque(tid) + h * NTHR; cplx r[16];
#pragma unroll
            for (int k = 0; k < 16; ++k) r[k] = Z[swz(j0 + 1024 * k)];
            inv16<10>(r, j0, T1, T2);
            __builtin_amdgcn_sched_barrier(0);
#pragma unroll
            for (int k = 0; k < 8; ++k) {
#pragma unroll
                for (int b = 0; b < 2; ++b) { const int t = j0 + 1024 * k; const f16* p = uT + (size_t)gch * M + b * SEQ + t;
                    const float um = t > 0 ? (float)p[-1] : 0.f, u0 = (float)p[0], up = t < SEQ - 1 ? (float)p[1] : 0.f;
                    const float gate = g_b + g_w0 * um + g_w1 * u0 + g_w2 * up;
                    const float zo = h ? zr[1][k][b] : zr[0][k][b]; const float zn = gate * (r[k][b] * (1.0f / NFFT) + bias * zo);
                    if (h) zr[1][k][b] = zn; else zr[0][k][b] = zn; }
                if ((k & 1) == 1) __builtin_amdgcn_sched_barrier(0); }
        }
        __syncthreads();
    }
#pragma unroll
    for (int h = 0; h < 2; ++h)
#pragma unroll
        for (int k = 0; k < 8; ++k)
#pragma unroll
            for (int b = 0; b < 2; ++b) uT[(size_t)c * M + b * SEQ + tid + h * NTHR + 1024 * k] = (f16)zr[h][k][b];
}

__device__ __forceinline__ void na_unit(const Args& A, int u, int lane) {
    bf16* Q = (bf16*)(A.ws + WS_Q); const bf16* Kb = (const bf16*)(A.ws + WS_K); const bf16* Vt = (const bf16*)(A.ws + WS_VT); const float* rpbp = (const float*)(A.ws + WS_RPB);
    const int jq = u & 3, r = (u >> 2) & 127, hh = (u >> 9) & 7, b = u >> 12, fr = lane & 15, fq = lane >> 4;
    const int rs = min(max(r - 4, 0), 120), wb = min(max(16 * jq - 8, 0), 32), c = 16 * jq + fr, cs = min(max(c - 8, 0), 48);
    const size_t qrow = (size_t)b * SEQ + r * 64 + c;
    const bf16x8 q0 = *(const bf16x8*)(Q + qrow * 512 + hh * 64 + 8 * fq), q1 = *(const bf16x8*)(Q + qrow * 512 + hh * 64 + 32 + 8 * fq);
    const int krow = wb + 8 * (fr >> 2) + (fr & 3);
    const int dc0 = wb + 8 * fq - c + 15;
    float s[8][8]; float mx = -1e30f;
#pragma unroll
    for (int a = 0; a < 8; ++a) { const int dr = rs + a - r + 7;
        const float* bp = rpbp + (hh * 15 + dr) * 48 + dc0 + 8;
        const f32x4 bv0 = *(const f32x4*)bp, bv1 = *(const f32x4*)(bp + 4);
#pragma unroll
        for (int ct = 0; ct < 2; ++ct) { const size_t tok = (size_t)b * SEQ + (rs + a) * 64 + krow + 4 * ct;
            const bf16x8 k0 = *(const bf16x8*)(Kb + tok * 512 + hh * 64 + 8 * fq), k1 = *(const bf16x8*)(Kb + tok * 512 + hh * 64 + 32 + 8 * fq);
            f32x4 acc = {0.f, 0.f, 0.f, 0.f};
            acc = __builtin_amdgcn_mfma_f32_16x16x32_bf16(k0, q0, acc, 0, 0, 0); acc = __builtin_amdgcn_mfma_f32_16x16x32_bf16(k1, q1, acc, 0, 0, 0);
#pragma unroll
            for (int i = 0; i < 4; ++i) { const int kc = wb + 8 * fq + 4 * ct + i; const bool ok = (kc >= cs) && (kc < cs + 16);
                const float v = ok ? acc[i] + (ct ? bv1[i] : bv0[i]) : -1e30f; s[a][4 * ct + i] = v; mx = fmaxf(mx, v); } } }
    mx = fmaxf(mx, __shfl_xor(mx, 16)); mx = fmaxf(mx, __shfl_xor(mx, 32));
    float sum = 0.f;
#pragma unroll
    for (int a = 0; a < 8; ++a)
#pragma unroll
        for (int j = 0; j < 8; ++j) { const float p = __expf(s[a][j] - mx); s[a][j] = p; sum += p; }
    sum += __shfl_xor(sum, 16); sum += __shfl_xor(sum, 32);
    const float inv = 1.0f / sum;
    f32x4 o[4];
#pragma unroll
    for (int dt = 0; dt < 4; ++dt) o[dt] = (f32x4){0.f, 0.f, 0.f, 0.f};
#pragma unroll
    for (int a = 0; a < 8; ++a) {
        u32x4 pw; pw.x = pkbf(s[a][0], s[a][1]); pw.y = pkbf(s[a][2], s[a][3]); pw.z = pkbf(s[a][4], s[a][5]); pw.w = pkbf(s[a][6], s[a][7]);
        const bf16x8 pb = __builtin_bit_cast(bf16x8, pw);
#pragma unroll
        for (int dt = 0; dt < 4; ++dt) { const bf16* vp = Vt + (((size_t)(b * 512 + hh * 64 + 16 * dt + fr)) << 13) + (rs + a) * 64 + wb + 8 * fq;
            const bf16x8 vf = *(const bf16x8*)vp;
            o[dt] = __builtin_amdgcn_mfma_f32_16x16x32_bf16(vf, pb, o[dt], 0, 0, 0); } }
#pragma unroll
    for (int dt = 0; dt < 4; ++dt) { u32x2 w; w.x = pkbf(o[dt][0] * inv, o[dt][1] * inv); w.y = pkbf(o[dt][2] * inv, o[dt][3] * inv);
        *(u32x2*)(Q + qrow * 512 + hh * 64 + 16 * dt + 4 * fq) = w; }
}

__device__ __forceinline__ void transpose_yb(const Args& A, LAS unsigned char* lds, int tid) {
    const f16* ybT = (const f16*)(A.ws + WS_UT); bf16* yb = (bf16*)(A.ws + WS_YB); LAS float* tl = (LAS float*)lds;
    for (int tile = blockIdx.x; tile < 8 * 256; tile += gridDim.x) { const int c0 = (tile & 7) * 64, k0 = (tile >> 3) * 64;
        { const int ci = tid >> 3, tj = (tid & 7) * 8; const f16x8 v = *(const f16x8*)(ybT + (size_t)(c0 + ci) * M + k0 + tj);
#pragma unroll
          for (int e = 0; e < 8; ++e) tl[ci * 65 + tj + e] = (float)v[e]; }
        __syncthreads();
        { const int ti = tid >> 3, cj = (tid & 7) * 8; float o[8];
#pragma unroll
          for (int e = 0; e < 8; ++e) o[e] = tl[(cj + e) * 65 + ti];
          u32x4 w; w.x = pkbf(o[0], o[1]); w.y = pkbf(o[2], o[3]); w.z = pkbf(o[4], o[5]); w.w = pkbf(o[6], o[7]);
          *(u32x4*)(yb + (size_t)(k0 + ti) * 512 + c0 + cj) = w; }
        __syncthreads();
    }
}
#define XB_TMO      128
#define XB_XCNT(j)  (256  + 64 * (j))
#define XB_XSUB(j)  (1280 + 64 * (j))
#define XB_XGEN(j)  (2304 + 64 * (j))
#define XB_TOP      3328
#define XB_TOPGEN   3392
#define XCD_BAR_WORDS 3456
#define XB_SPIN_CAP (1u << 18)

__device__ __forceinline__ unsigned xb_ld(unsigned* p)              { return __hip_atomic_load(p, __ATOMIC_RELAXED, __HIP_MEMORY_SCOPE_AGENT); }
__device__ __forceinline__ unsigned xb_add(unsigned* p, unsigned v) { return __hip_atomic_fetch_add(p, v, __ATOMIC_RELAXED, __HIP_MEMORY_SCOPE_AGENT); }
__device__ __forceinline__ unsigned xb_xcc_id() { return (unsigned)__builtin_amdgcn_s_getreg((3 << 11) | 20) & 0xFu; }
#define XB_SPIN(cond, bar) do { unsigned _sp = 0; while (cond) { __builtin_amdgcn_s_sleep(1); \
    if ((++_sp & 255u) == 0u) { if (xb_ld(&(bar)[XB_TMO])) break; if (_sp > XB_SPIN_CAP) { atomicAdd(&(bar)[XB_TMO], 1u); break; } } } } while (0)

struct XcdBarrier {
    unsigned* bar; unsigned x;
    volatile LAS unsigned* st;
};

__device__ __forceinline__ XcdBarrier xcd_barrier_post(unsigned* bar, volatile LAS unsigned* st) {
    XcdBarrier b; b.bar = bar; b.x = xb_xcc_id(); b.st = st;
    if (threadIdx.x == 0) (void)xb_add(&bar[XB_XCNT(b.x)], 1u);
    return b;
}
__device__ __forceinline__ void xcd_barrier_complete(unsigned* bar, unsigned x, unsigned& nloc, unsigned& nx) {
    const unsigned G = gridDim.x * gridDim.y * gridDim.z;
    unsigned sum, cnt, mine, sp = 0u;
    for (;;) {
        sum = 0u; cnt = 0u; mine = 0u;
#pragma unroll
        for (unsigned j = 0; j < 16; ++j) { const unsigned c = xb_ld(&bar[XB_XCNT(j)]); sum += c; cnt += (c > 0u) ? 1u : 0u; mine = (j == x) ? c : mine; }
        if (sum == G) break;
        __builtin_amdgcn_s_sleep(1);
        if ((++sp & 255u) == 0u) { if (xb_ld(&bar[XB_TMO])) break; if (sp > XB_SPIN_CAP) { atomicAdd(&bar[XB_TMO], 1u); break; } }
    }
    nloc = mine > 0u ? mine : 1u; nx = cnt > 0u ? cnt : 1u;
}

__device__ __forceinline__ void xcd_barrier(const XcdBarrier& b) {
    asm volatile("s_waitcnt vmcnt(0)" ::: "memory");
    __syncthreads();
    if (threadIdx.x == 0) {
        unsigned* bar = b.bar;
        __builtin_amdgcn_s_waitcnt(0);
        unsigned nloc = b.st[0], nx = b.st[1];
        if (nloc == 0u) { xcd_barrier_complete(bar, b.x, nloc, nx); b.st[0] = nloc; b.st[1] = nx; }
        const unsigned old = xb_add(&bar[XB_XSUB(b.x)], 1u);
        const unsigned gen = old / nloc;
        if (old + 1u == (gen + 1u) * nloc) {
            __builtin_amdgcn_fence(__ATOMIC_RELEASE, "agent");
            asm volatile("s_waitcnt vmcnt(0)" ::: "memory");
            const unsigned og = xb_add(&bar[XB_TOP], 1u);
            const unsigned tg = og / nx;
            if (og + 1u == (tg + 1u) * nx) xb_add(&bar[XB_TOPGEN], 1u);
            else XB_SPIN(xb_ld(&bar[XB_TOPGEN]) == tg, bar);
            __builtin_amdgcn_fence(__ATOMIC_ACQUIRE, "agent");
            xb_add(&bar[XB_XGEN(b.x)], 1u);
            asm volatile("s_waitcnt vmcnt(0)" ::: "memory");
        } else {
            XB_SPIN(xb_ld(&bar[XB_XGEN(b.x)]) == gen, bar);
            __builtin_amdgcn_fence(__ATOMIC_ACQUIRE, "agent");
            asm volatile("s_waitcnt vmcnt(0)" ::: "memory");
        }
    }
    __syncthreads();
}

__global__ void __launch_bounds__(NTHR, 2) mk_fwd(Args A) {
    extern __shared__ __attribute__((aligned(16))) unsigned char lds_raw[];
    LAS unsigned char* lds = (LAS unsigned char*)lds_raw;
    const int tid = threadIdx.x, lane = tid & 63, wave = __builtin_amdgcn_readfirstlane(tid >> 6);
    cg::grid_group grid = cg::this_grid();
    if (tid < 2) ((volatile LAS unsigned*)(lds + 140000))[tid] = 0u;
    __syncthreads();
    XcdBarrier xbar = xcd_barrier_post((unsigned*)A.ws + 4096, (volatile LAS unsigned*)(lds + 140000));
    const int lo = A.ph_lo, hi = A.ph_hi, G = gridDim.x, bx = blockIdx.x;
    unsigned char* ws = A.ws;
#ifndef PMASK
#define PMASK 0x3fff
#endif
#define IN(k) (((PMASK >> (k)) & 1) && ((lo <= (k) && (k) < hi) || ((k) == 13 && lo <= 6 && hi >= 8) || (lo == 13 && (k) == 13)))
#define GSYNC() do { xcd_barrier(xbar); } while (0)
#define SEAM(k) do { if (IN(k) && IN((k) + 1)) GSYNC(); } while (0)
    bf16* XB = (bf16*)(ws + WS_XB); bf16* HB = (bf16*)(ws + WS_H); float* R = A.out;

    if (IN(0)) { p0_prologue(A, lds, tid, lane, wave); }
    SEAM(0);
    if (IN(1)) { pg8::Gemm g{XB, (const bf16*)(ws + WS_W13A), M, 2 * FF, D}; pg8::StaticOrder S; S.init(M, 2 * FF, G, bx); EpiSwiglu E{HB};
                 pg8::gemm_phase<EpiSwiglu, pg8::StaticOrder, true, true>(lds, g, S, E); } SEAM(1);
    if (IN(2)) { pg8::Gemm g{HB, (const bf16*)(ws + WS_W2A), M, D, FF}; pg8::StaticOrder S; S.init(M, D, G, bx); EpiResid E{A.in[0], R, 0.5f};
                 pg8::gemm_phase<EpiResid, pg8::StaticOrder, true, true>(lds, g, S, E); } SEAM(2);
    if (IN(3)) { ln_phase(R, R, XB, A.in[1], A.in[2], lane, wave); } SEAM(3);
    if (IN(4)) { pg8::Gemm g{XB, (const bf16*)(ws + WS_WIN), M, 3072, D}; pg8::StaticOrder S; S.init(M, 3072, G, bx);
                 EpiIn E{(bf16*)(ws + WS_Q), (bf16*)(ws + WS_K), (bf16*)(ws + WS_VT), (f16*)(ws + WS_UT)};
                 pg8::gemm_phase<EpiIn, pg8::StaticOrder, true, true>(lds, g, S, E); } SEAM(4);
    if (IN(5)) {
        if (tid < 256) { float s, c; const int k = tid & 127; sincospif(tid < 128 ? -(float)k * (1.0f / 64.0f) : -(float)k * (1.0f / 8192.0f), &s, &c);
            ((LAS cplx*)(lds + 131072))[tid] = (cplx){c, s}; }
        __syncthreads();
        #ifndef NO_HY
        for (int c = bx; c < 512; c += G) hyena_channel(A, lds, c, tid);
#endif
        #ifndef NO_NA
        for (int u = bx * NWAVES + wave; u < 8192; u += G * NWAVES) na_unit(A, u, lane);
#endif
    } SEAM(5);
    if (IN(6)) { transpose_yb(A, lds, tid); } SEAM(6);
    if (IN(13)) { pg8::Gemm g{XB, (const bf16*)(ws + WS_WIN) + (size_t)3072 * D, M, 2048, D}; pg8::StaticOrder S; S.init(M, 2048, G, bx); EpiGate E{(bf16*)(ws + WS_GATE), A.in[7]};
                  pg8::gemm_phase<EpiGate, pg8::StaticOrder, true, true>(lds, g, S, E); }
    if (IN(13) && IN(7)) GSYNC();
    if (IN(7)) { pg8::StaticOrder S; S.init(M, D, G, bx);
                 { pg8::Gemm g{(const bf16*)(ws + WS_Q), (const bf16*)(ws + WS_WPA), M, D, 512}; EpiMix<0> E{(bf16*)(ws + WS_MIX), (const bf16*)(ws + WS_GATE)};
                   pg8::gemm_phase<EpiMix<0>, pg8::StaticOrder, true, true>(lds, g, S, E); }
                 { pg8::Gemm g{(const bf16*)(ws + WS_YB), (const bf16*)(ws + WS_WPB), M, D, 512}; EpiMix<1> E{(bf16*)(ws + WS_MIX), (const bf16*)(ws + WS_GATE)};
                   pg8::gemm_phase<EpiMix<1>, pg8::StaticOrder, true, true>(lds, g, S, E); } } SEAM(7);
    if (IN(8)) { pg8::Gemm g{(const bf16*)(ws + WS_MIX), (const bf16*)(ws + WS_WOUT), M, D, D}; pg8::StaticOrder S; S.init(M, D, G, bx); EpiResid E{R, R, 1.0f};
                 pg8::gemm_phase<EpiResid, pg8::StaticOrder, true, true>(lds, g, S, E); } SEAM(8);
    if (IN(9)) { ln_phase(R, R, XB, A.in[22], A.in[23], lane, wave); } SEAM(9);
    if (IN(10)) { pg8::Gemm g{XB, (const bf16*)(ws + WS_W13B), M, 2 * FF, D}; pg8::StaticOrder S; S.init(M, 2 * FF, G, bx); EpiSwiglu E{HB};
                  pg8::gemm_phase<EpiSwiglu, pg8::StaticOrder, true, true>(lds, g, S, E); } SEAM(10);
    if (IN(11)) { pg8::Gemm g{HB, (const bf16*)(ws + WS_W2B), M, D, FF}; pg8::StaticOrder S; S.init(M, D, G, bx); EpiResid E{R, R, 0.5f};
                  pg8::gemm_phase<EpiResid, pg8::StaticOrder, true, true>(lds, g, S, E); } SEAM(11);
    if (IN(12)) { ln_phase(R, R, nullptr, A.in[27], A.in[28], lane, wave); }
#undef IN
#undef SEAM
}

extern "C" void kernel_launch(void* const* d_in, const int* in_sizes, int n_in, void* d_out, int out_size, void* d_ws, size_t ws_size, hipStream_t stream) {
    static int grid = 0;
    if (grid == 0) {
        if (n_in != 29 || in_sizes[0] != M * D || out_size != M * D || ws_size < WS_END) { fprintf(stderr, "kernel_launch: unexpected problem shape (n_in %d, ws %zu)\n", n_in, ws_size); grid = -1; return; }
        int dev = 0, cus = 0, per_cu = 0;
        (void)hipGetDevice(&dev); (void)hipDeviceGetAttribute(&cus, hipDeviceAttributeMultiprocessorCount, dev);
        if (hipFuncSetAttribute((const void*)mk_fwd, hipFuncAttributeMaxDynamicSharedMemorySize, LDS_BYTES) != hipSuccess) fprintf(stderr, "kernel_launch: hipFuncSetAttribute failed\n");
        if (hipOccupancyMaxActiveBlocksPerMultiprocessor(&per_cu, (const void*)mk_fwd, NTHR, LDS_BYTES) != hipSuccess || per_cu < 1) { fprintf(stderr, "kernel_launch: occupancy query says %d blocks per CU\n", per_cu); per_cu = 1; }
        (void)hipGetLastError();
        grid = cus * per_cu; if (grid > 256) grid = 256; if (grid < 1) grid = 1;
    }
    if (grid < 0) return;
    (void)hipMemsetAsync(d_ws, 0, 65536, stream);
    Args a{};
    for (int i = 0; i < 29; ++i) a.in[i] = (const float*)d_in[i];
    a.out = (float*)d_out; a.ws = (unsigned char*)d_ws;
#if MK_PER_PHASE
    const int order[14] = {0, 1, 2, 3, 4, 5, 6, 13, 7, 8, 9, 10, 11, 12};
    for (int i = 0; i < 14; ++i) { a.ph_lo = order[i]; a.ph_hi = order[i] + 1; hipLaunchKernelGGL(mk_fwd, dim3(grid), dim3(NTHR), LDS_BYTES, stream, a); }
#else
    a.ph_lo = 0; a.ph_hi = NPHASE;
    void* args[] = {&a};
    const hipError_t e = hipLaunchCooperativeKernel((const void*)mk_fwd, dim3(grid), dim3(NTHR), args, LDS_BYTES, stream);
    if (e != hipSuccess) fprintf(stderr, "kernel_launch: cooperative launch failed: %s (grid %d)\n", hipGetErrorString(e), grid);
#endif
}
```
